# Optimizing an MI355X kernel written in HIP

```python
import jax, jax.numpy as jnp
from jax import lax
import numpy as np

D_MODEL = 2048
BATCH = 2
SEQ = 16384
DEPTH = 1

RET_HEADS = 8
RET_QK_DIM = 128
RET_V_DIM = 128
RET_QK_WIDTH = RET_HEADS * RET_QK_DIM
RET_WIDTH = RET_HEADS * RET_V_DIM
CONV_WIDTH = D_MODEL // 2
CONV_GROUPS = 8
CONV_K = 3
CHUNK = 128
N_BRANCH = 2
ROPE_BASE = 10000.0
EPS = 1e-6
COL_SIZES = (RET_QK_WIDTH, RET_QK_WIDTH, RET_WIDTH, RET_WIDTH,
             CONV_WIDTH, CONV_WIDTH, CONV_WIDTH, CONV_WIDTH,
             N_BRANCH * D_MODEL)
COL_SPLITS = tuple(int(c) for c in np.cumsum(COL_SIZES)[:-1])
IN_COLS = int(sum(COL_SIZES))
BRANCH_WIDTH = RET_WIDTH

kernel_name = "hybrid_retention_shortconv_gated_block"


def rmsnorm(x, gain):
    xf = x.astype(jnp.float32)
    y = xf * lax.rsqrt(jnp.mean(xf * xf, axis=-1, keepdims=True) + EPS)
    return (y * gain.astype(jnp.float32)).astype(x.dtype)


def rotary(x):
    s, dh = x.shape[1], x.shape[-1]
    pos = jnp.arange(s, dtype=jnp.float32)
    inv_freq = ROPE_BASE ** (-jnp.arange(0, dh, 2, dtype=jnp.float32) / dh)
    ang = pos[:, None] * inv_freq[None, :]
    cos = jnp.cos(ang)[None, :, None, :]
    sin = jnp.sin(ang)[None, :, None, :]
    xf = x.astype(jnp.float32)
    x1, x2 = jnp.split(xf, 2, axis=-1)
    return jnp.concatenate([x1 * cos - x2 * sin, x2 * cos + x1 * sin], axis=-1)


def retention_dir(q, k, v, log_gamma, strict):
    b, h, s, dk = q.shape
    dv = v.shape[-1]
    n = s // CHUNK
    qc = q.reshape(b, h, n, CHUNK, dk)
    kc = k.reshape(b, h, n, CHUNK, dk)
    vc = v.reshape(b, h, n, CHUNK, dv)
    pos = jnp.arange(CHUNK, dtype=jnp.float32)
    diff = pos[:, None] - pos[None, :]
    mask = (diff > 0) if strict else (diff >= 0)
    lg = log_gamma[:, None, None]
    decay = jnp.where(mask[None], jnp.exp(jnp.where(mask, diff, 0.0)[None] * lg), 0.0)
    scores = jnp.einsum('bhncd,bhnld->bhncl', qc, kc) * decay[None, :, None]
    intra = jnp.einsum('bhncl,bhnle->bhnce', scores, vc)
    k_w = jnp.exp((CHUNK - pos)[None, :] * log_gamma[:, None])
    kv = jnp.einsum('bhncd,hc,bhnce->bhnde', kc, k_w, vc)
    chunk_decay = jnp.exp(CHUNK * log_gamma)[None, :, None, None]

    def step(state, kv_n):
        return chunk_decay * state + kv_n, state

    _, states = lax.scan(step, jnp.zeros((b, h, dk, dv), jnp.float32), jnp.moveaxis(kv, 2, 0))
    states = jnp.moveaxis(states, 0, 2)
    q_w = jnp.exp(pos[None, :] * log_gamma[:, None])
    cross = jnp.einsum('bhncd,hc,bhnde->bhnce', qc, q_w, states)
    return (intra + cross).reshape(b, h, s, dv)


def bidirectional_retention(q, k, v, logit_fwd, logit_bwd):
    lg_f = jax.nn.log_sigmoid(logit_fwd.astype(jnp.float32))
    lg_b = jax.nn.log_sigmoid(logit_bwd.astype(jnp.float32))
    fwd = retention_dir(q, k, v, lg_f, strict=False)
    flip = lambda t: jnp.flip(t, axis=2)
    bwd = flip(retention_dir(flip(q), flip(k), flip(v), lg_b, strict=True))
    return fwd + bwd


def short_conv_centred(u, w):
    rhs = w[:, None, :].astype(u.dtype)
    return lax.conv_general_dilated(
        u, rhs, window_strides=(1,), padding=[(CONV_K // 2, CONV_K // 2)],
        dimension_numbers=('NWC', 'WIO', 'NWC'), feature_group_count=u.shape[-1])


def setup_inputs(seed: int = 0) -> dict:
    key = jax.random.key(seed)
    ks = jax.random.split(key, 12)
    f32 = jnp.float32
    x = jax.random.normal(ks[0], (BATCH, SEQ, D_MODEL), f32)
    norm_gain = 1.0 + 0.02 * jax.random.normal(ks[1], (DEPTH, D_MODEL), f32)
    w_in = jax.random.normal(ks[2], (DEPTH, D_MODEL, IN_COLS), f32) * D_MODEL ** -0.5
    base_logit = jnp.log(2.0 ** (5.0 + jnp.arange(RET_HEADS, dtype=f32)) - 1.0)
    decay_logit_fwd = base_logit[None] + 0.1 * jax.random.normal(ks[3], (DEPTH, RET_HEADS), f32)
    decay_logit_bwd = base_logit[None] + 0.1 * jax.random.normal(ks[4], (DEPTH, RET_HEADS), f32)
    ret_gn_gain = 1.0 + 0.02 * jax.random.normal(ks[5], (DEPTH, RET_WIDTH), f32)
    conv_w = jax.random.normal(ks[6], (DEPTH, CONV_K, CONV_WIDTH), f32) * CONV_K ** -0.5
    w_branch = jax.random.normal(ks[7], (DEPTH, N_BRANCH, BRANCH_WIDTH, D_MODEL), f32) * BRANCH_WIDTH ** -0.5
    w_out = jax.random.normal(ks[8], (DEPTH, D_MODEL, D_MODEL), f32) * D_MODEL ** -0.5
    final_gain = 1.0 + 0.02 * jax.random.normal(ks[9], (D_MODEL,), f32)
    return {"x": x, "norm_gain": norm_gain, "w_in": w_in,
            "decay_logit_fwd": decay_logit_fwd, "decay_logit_bwd": decay_logit_bwd,
            "ret_gn_gain": ret_gn_gain, "conv_w": conv_w, "w_branch": w_branch,
            "w_out": w_out, "final_gain": final_gain}


def reference(x, norm_gain, w_in, decay_logit_fwd, decay_logit_bwd, ret_gn_gain,
              conv_w, w_branch, w_out, final_gain):
    b, s, _ = x.shape
    for layer in range(DEPTH):
        h = rmsnorm(x, norm_gain[layer])
        proj = jnp.einsum('bsd,df->bsf', h, w_in[layer])
        q, k, v, g_ret, c_b, c_c, c_x, g_conv, merge_logits = jnp.split(proj, COL_SPLITS, axis=-1)

        q = rotary(q.reshape(b, s, RET_HEADS, RET_QK_DIM))
        k = rotary(k.reshape(b, s, RET_HEADS, RET_QK_DIM)) * (RET_QK_DIM ** -0.5)
        v = v.reshape(b, s, RET_HEADS, RET_V_DIM).astype(jnp.float32)
        to_bhsd = lambda t: jnp.transpose(t, (0, 2, 1, 3))
        o = bidirectional_retention(to_bhsd(q), to_bhsd(k), to_bhsd(v),
                                    decay_logit_fwd[layer], decay_logit_bwd[layer])
        o = jnp.transpose(o, (0, 2, 1, 3))
        o = o * lax.rsqrt(jnp.mean(o * o, axis=-1, keepdims=True) + EPS)
        o = o.reshape(b, s, RET_WIDTH) * ret_gn_gain[layer].astype(jnp.float32)
        branch_ret = (o * jax.nn.silu(g_ret.astype(jnp.float32))).astype(x.dtype)

        conv = short_conv_centred(c_c * c_x, conv_w[layer])
        branch_conv = c_b * conv * jax.nn.silu(g_conv)

        branches = jnp.stack([branch_ret, branch_conv], axis=2)
        up = jnp.einsum('bsnf,nfd->bsnd', branches, w_branch[layer])
        gates = jax.nn.sigmoid(merge_logits.reshape(b, s, N_BRANCH, D_MODEL))
        merged = jnp.sum(gates * up, axis=2)
        out = jnp.einsum('bsd,de->bse', merged, w_out[layer])
        x = x + out.astype(x.dtype)
    return rmsnorm(x, final_gain)
```

```cpp
#include <hip/hip_runtime.h>
#include <hip/hip_cooperative_groups.h>
#include <cstdio>
namespace cg = cooperative_groups;

#define LAS __attribute__((address_space(3)))
typedef unsigned short bf16_t;
typedef short bf16x8 __attribute__((ext_vector_type(8)));
typedef float f32x4 __attribute__((ext_vector_type(4)));
typedef unsigned u32x4 __attribute__((ext_vector_type(4)));
typedef unsigned u32x2 __attribute__((ext_vector_type(2)));

constexpr int T_TOK = 32768, DM = 2048, SEQ = 16384, NCOL = 12288;
constexpr size_t MiB = 1ull << 20;
constexpr size_t WS_H = 0, WS_KV = 0, WS_WIN = 128 * MiB, WS_WB = 176 * MiB, WS_WO = 184 * MiB, WS_COS = 192 * MiB, WS_SIN = 196 * MiB,
                 WS_Q = 200 * MiB, WS_K = 264 * MiB, WS_MERGED = 200 * MiB, WS_V = 328 * MiB, WS_SG = 392 * MiB, WS_UW = 456 * MiB, WS_ST = 456 * MiB,
                 WS_GATE = 584 * MiB, WS_BR = 840 * MiB, WS_SSQ = 968 * MiB, WS_END = 972 * MiB;
constexpr int LDS_BYTES = 147456;
constexpr int TS = 136;

struct Params {
    const float* x; const float* norm_gain; const float* w_in; const float* lg_f; const float* lg_b; const float* gn_gain;
    const float* conv_w; const float* w_branch; const float* w_out; const float* final_gain; float* out; unsigned char* ws;
};

typedef __bf16 bf16x2_t __attribute__((ext_vector_type(2)));
typedef float f32x2_t __attribute__((ext_vector_type(2)));
__device__ __forceinline__ unsigned cvt_pk_bf16(float lo, float hi) { f32x2_t v = {lo, hi}; bf16x2_t b = __builtin_convertvector(v, bf16x2_t); return __builtin_bit_cast(unsigned, b); }
__device__ __forceinline__ bf16_t f2bf(float f) { unsigned u = __float_as_uint(f); u += 0x7FFFu + ((u >> 16) & 1u); return (bf16_t)(u >> 16); }
__device__ __forceinline__ float bf_lo(unsigned w) { return __uint_as_float(w << 16); }
__device__ __forceinline__ float bf_hi(unsigned w) { return __uint_as_float(w & 0xffff0000u); }
__device__ __forceinline__ float sigmoidf_(float x) { return __builtin_amdgcn_rcpf(1.0f + __expf(-x)); }
__device__ __forceinline__ float log2_sigmoid(float x) { return -log1pf(expf(-x)) * 1.4426950408889634f; }

namespace pg8 {
constexpr int BM = 256, BK = 64, HALF = 128, HTB = HALF * BK * 2, STAGE_BYTES = 8 * HTB, NXCD = 8, WGM = 8;
__host__ __device__ __forceinline__ int lds_byte(int r, int c) { const int st = (r >> 4) * 2 + (c >> 5), rr = r & 15, cc = c & 31, ob = rr * 64 + cc * 2; return st * 1024 + (ob ^ (((ob >> 9) & 1) << 5)); }
__host__ __device__ __forceinline__ void stage_rc(int b, int& R, int& C) { const int st = b / 1024, sb = b % 1024, swz = sb ^ (((sb >> 9) & 1) << 5); R = (st >> 1) * 16 + swz / 64; C = (st & 1) * 32 + (swz % 64) / 2; }
__host__ __device__ __forceinline__ int perm32(int rho) { const int n = rho >> 4, i = rho & 15; return 8 * (i >> 2) + 4 * n + (i & 3); }

struct Unit { int pm, pn, z; };
struct Gemm { const bf16_t* A; const bf16_t* Bt; int M, N, K; size_t zA, zB; };

struct Order {
    int nM, nN, nwg, G, c, zsh;
    __device__ void init(int M, int N, int G_, int c_, int zsh_) { nM = M / BM; nN = N / BM; nwg = nM * nN; G = G_; c = c_; zsh = zsh_; }
    __device__ bool next(int i, Unit& u) const {
        const int ti = i >> zsh; u.z = i & ((1 << zsh) - 1);
        const long L = (long)ti * G + c; if (L >= nwg) return false;
        int wgid = (int)L; { const int q = nwg / NXCD, r = nwg % NXCD, xcd = wgid % NXCD, off = wgid / NXCD; wgid = (xcd < r ? xcd * (q + 1) : r * (q + 1) + (xcd - r) * q) + off; }
        const int nig = WGM * nN, gid = wgid / nig, fm = gid * WGM, gsz = (nM - fm) < WGM ? (nM - fm) : WGM;
        u.pm = fm + ((wgid % nig) % gsz); u.pn = (wgid % nig) / gsz; return true;
    }
};

template <class Epi>
__device__ __forceinline__ void gemm_phase(LAS unsigned char* lds, const Gemm g, const Order& S, const Epi& E) {
    const int tid = threadIdx.x, wid = __builtin_amdgcn_readfirstlane(tid >> 6), lane = tid & 63, wr = wid >> 2, wc = wid & 3, fr = lane & 15, fq = lane >> 4;
    const int K = g.K, nt = K / BK;
    unsigned voffA[2], voffB[2];
#pragma unroll
    for (int i = 0; i < 2; ++i) { int R, C; stage_rc(tid * 16 + i * 8192, R, C); const int Rb = Epi::PERM ? ((R & ~31) + perm32(R & 31)) : R;
        voffA[i] = (unsigned)(R * K + C) * 2u; voffB[i] = (unsigned)(Rb * K + C) * 2u; }
    const size_t kstep = (size_t)(BK * 2);
    const size_t hstep = (size_t)HALF * K * 2;
    const size_t tstep = 2 * hstep;
    const unsigned ldsw = (unsigned)wid * 1024u;
    const int aoff = lds_byte(wr * 64 + fr, fq * 8), boff = lds_byte(wc * 32 + fr, fq * 8);
#define PG8_SA(b, h) (((b) * 2 + (h)) * HTB)
#define PG8_SB(b, h) ((4 + (b) * 2 + (h)) * HTB)
#define PG8_STAGE(bufoff, gbase, voff) do { _Pragma("unroll") for (int _i = 0; _i < 2; ++_i) \
        __builtin_amdgcn_global_load_lds((const unsigned*)((const char*)(gbase) + (voff)[_i]), (LAS unsigned*)(lds + (bufoff) + ldsw + _i * 8192), 16, 0, 0); } while (0)
#define PG8_LDA(dst, b, h) do { _Pragma("unroll") for (int m = 0; m < 4; ++m) _Pragma("unroll") for (int k = 0; k < 2; ++k) dst[m][k] = *(const LAS bf16x8*)(lds + PG8_SA(b, h) + aoff + m * 2048 + k * 1024); } while (0)
#define PG8_LDB(dst, b, h) do { _Pragma("unroll") for (int n = 0; n < 2; ++n) _Pragma("unroll") for (int k = 0; k < 2; ++k) dst[n][k] = *(const LAS bf16x8*)(lds + PG8_SB(b, h) + boff + n * 2048 + k * 1024); } while (0)
#define PG8_MMA(ai, bj, At, Bt) do { __builtin_amdgcn_s_setprio(1); _Pragma("unroll") for (int m = 0; m < 4; ++m) _Pragma("unroll") for (int n = 0; n < 2; ++n) _Pragma("unroll") for (int k = 0; k < 2; ++k) \
        acc[ai][bj][m][n] = __builtin_amdgcn_mfma_f32_16x16x32_bf16(Bt[n][k], At[m][k], acc[ai][bj][m][n], 0, 0, 0); __builtin_amdgcn_s_setprio(0); } while (0)
#define PG8_WAIT_V(n) asm volatile("s_waitcnt vmcnt(" #n ")" ::: "memory")
#define PG8_WAIT_L(n) asm volatile("s_waitcnt lgkmcnt(" #n ")" ::: "memory")
#define PG8_BAR __builtin_amdgcn_s_barrier()
#define PG8_SCHED __builtin_amdgcn_sched_barrier(0)
    Unit cur, nxt; int ui = 0;
    if (!S.next(0, cur)) return;
    f32x4 acc[2][2][4][2];
#pragma unroll
    for (int a = 0; a < 2; ++a)
#pragma unroll
        for (int b = 0; b < 2; ++b)
#pragma unroll
            for (int m = 0; m < 4; ++m)
#pragma unroll
                for (int n = 0; n < 2; ++n) acc[a][b][m][n] = (f32x4){0.f, 0.f, 0.f, 0.f};
    bf16x8 At[4][2], B0[2][2], B1[2][2];
    const char* cA = (const char*)g.A + (size_t)cur.pm * tstep + (size_t)cur.z * g.zA; const char* cB = (const char*)g.Bt + (size_t)cur.pn * tstep + (size_t)cur.z * g.zB;
    PG8_STAGE(PG8_SB(0, 0), cB, voffB); PG8_STAGE(PG8_SA(0, 0), cA, voffA); PG8_STAGE(PG8_SB(0, 1), cB + hstep, voffB); PG8_STAGE(PG8_SA(0, 1), cA + hstep, voffA);
    if (wr == 1) PG8_BAR;
    PG8_WAIT_V(4); PG8_BAR;
    PG8_STAGE(PG8_SB(1, 0), cB + kstep, voffB); PG8_STAGE(PG8_SA(1, 0), cA + kstep, voffA); PG8_STAGE(PG8_SB(1, 1), cB + hstep + kstep, voffB);
    PG8_WAIT_V(6); PG8_BAR;
    for (;;) {
        const bool has_next = S.next(ui + 1, nxt);
        const char* nA = has_next ? (const char*)g.A + (size_t)nxt.pm * tstep + (size_t)nxt.z * g.zA : cA;
        const char* nB = has_next ? (const char*)g.Bt + (size_t)nxt.pn * tstep + (size_t)nxt.z * g.zB : cB;
        for (int t = 0; t < nt; t += 2) {
            const bool last = (t == nt - 2);
            const char* a1 = cA + (size_t)(t + 1) * kstep;
            const char* a2 = last ? nA : cA + (size_t)(t + 2) * kstep; const char* b2 = last ? nB : cB + (size_t)(t + 2) * kstep;
            const char* a3 = a2 + kstep; const char* b3 = b2 + kstep;
            PG8_LDB(B0, 0, 0); PG8_SCHED; PG8_LDA(At, 0, 0); PG8_STAGE(PG8_SA(1, 1), a1 + hstep, voffA);
            PG8_WAIT_L(8); PG8_BAR; PG8_WAIT_L(0); PG8_MMA(0, 0, At, B0); PG8_BAR; PG8_SCHED;
            PG8_LDB(B1, 0, 1); PG8_STAGE(PG8_SB(0, 0), b2, voffB);
            PG8_BAR; PG8_WAIT_L(0); PG8_MMA(0, 1, At, B1); PG8_BAR;
            PG8_LDA(At, 0, 1); PG8_STAGE(PG8_SA(0, 0), a2, voffA);
            PG8_BAR; PG8_WAIT_L(0); PG8_MMA(1, 0, At, B0); PG8_BAR; PG8_SCHED;
            PG8_STAGE(PG8_SB(0, 1), b2 + hstep, voffB);
            PG8_WAIT_V(6); PG8_BAR; PG8_MMA(1, 1, At, B1); PG8_BAR;
            PG8_LDB(B0, 1, 0); PG8_SCHED; PG8_LDA(At, 1, 0); PG8_STAGE(PG8_SA(0, 1), a2 + hstep, voffA);
            PG8_WAIT_L(8); PG8_BAR; PG8_WAIT_L(0); PG8_MMA(0, 0, At, B0); PG8_BAR; PG8_SCHED;
            PG8_LDB(B1, 1, 1); PG8_STAGE(PG8_SB(1, 0), b3, voffB);
            PG8_BAR; PG8_WAIT_L(0); PG8_MMA(0, 1, At, B1); PG8_BAR;
            PG8_LDA(At, 1, 1); PG8_STAGE(PG8_SA(1, 0), a3, voffA);
            PG8_BAR; PG8_WAIT_L(0); PG8_MMA(1, 0, At, B0); PG8_BAR; PG8_SCHED;
            PG8_STAGE(PG8_SB(1, 1), b3 + hstep, voffB);
            PG8_WAIT_V(6); PG8_BAR; PG8_MMA(1, 1, At, B1); PG8_BAR;
        }
        E(acc, cur, wr, wc, fr, fq);
        if (!has_next) break;
#pragma unroll
        for (int a = 0; a < 2; ++a)
#pragma unroll
            for (int b = 0; b < 2; ++b)
#pragma unroll
                for (int m = 0; m < 4; ++m)
#pragma unroll
                    for (int n = 0; n < 2; ++n) acc[a][b][m][n] = (f32x4){0.f, 0.f, 0.f, 0.f};
        cur = nxt; cA = nA; cB = nB; ++ui;
    }
    PG8_WAIT_V(0);
    if (wr == 0) PG8_BAR;
    PG8_BAR;
#undef PG8_SA
#undef PG8_SB
#undef PG8_STAGE
#undef PG8_LDA
#undef PG8_LDB
#undef PG8_MMA
#undef PG8_WAIT_V
#undef PG8_WAIT_L
#undef PG8_BAR
#undef PG8_SCHED
}
}

struct Epi1 {
    static constexpr bool PERM = true;
    bf16_t *Q, *K, *V, *SG, *UW, *GATE; const float *COS, *SIN;
    __device__ __forceinline__ void operator()(const f32x4 (&acc)[2][2][4][2], const pg8::Unit& u, int wr, int wc, int fr, int fq) const {
        const int row0 = u.pm * 256 + wr * 64 + fr, lc = wc * 32 + 8 * fq, pn = u.pn;
        if (pn < 8) {
            bf16_t* base = (pn < 4 ? Q : K) + (pn & 3) * 256 + lc;
            const int i0 = lc >> 1;
#pragma unroll
            for (int ai = 0; ai < 2; ++ai)
#pragma unroll
                for (int m = 0; m < 4; ++m) {
                    const int row = row0 + ai * 128 + m * 16, pos = row & (SEQ - 1);
                    const f32x4 cs = *(const f32x4*)(COS + pos * 64 + i0), sn = *(const f32x4*)(SIN + pos * 64 + i0);
#pragma unroll
                    for (int bj = 0; bj < 2; ++bj) {
                        const f32x4 v0 = acc[ai][bj][m][0], v1 = acc[ai][bj][m][1]; u32x4 w;
                        w.x = cvt_pk_bf16(v0[0] * cs[0] - v0[1] * sn[0], v0[1] * cs[0] + v0[0] * sn[0]);
                        w.y = cvt_pk_bf16(v0[2] * cs[1] - v0[3] * sn[1], v0[3] * cs[1] + v0[2] * sn[1]);
                        w.z = cvt_pk_bf16(v1[0] * cs[2] - v1[1] * sn[2], v1[1] * cs[2] + v1[0] * sn[2]);
                        w.w = cvt_pk_bf16(v1[2] * cs[3] - v1[3] * sn[3], v1[3] * cs[3] + v1[2] * sn[3]);
                        *(u32x4*)(base + (size_t)row * 1024 + bj * 128) = w; }
                }
        } else if (pn < 16) {
            const bool act = pn >= 12;
            bf16_t* base = (act ? SG : V) + (pn & 3) * 256 + lc;
#pragma unroll
            for (int ai = 0; ai < 2; ++ai)
#pragma unroll
                for (int m = 0; m < 4; ++m) {
                    const int row = row0 + ai * 128 + m * 16;
#pragma unroll
                    for (int bj = 0; bj < 2; ++bj) {
                        f32x4 v0 = acc[ai][bj][m][0], v1 = acc[ai][bj][m][1];
                        if (act) {
#pragma unroll
                            for (int j = 0; j < 4; ++j) { v0[j] = v0[j] * sigmoidf_(v0[j]); v1[j] = v1[j] * sigmoidf_(v1[j]); } }
                        u32x4 w; w.x = cvt_pk_bf16(v0[0], v0[1]); w.y = cvt_pk_bf16(v0[2], v0[3]); w.z = cvt_pk_bf16(v1[0], v1[1]); w.w = cvt_pk_bf16(v1[2], v1[3]);
                        *(u32x4*)(base + (size_t)row * 1024 + bj * 128) = w; }
                }
        } else if (pn < 32) {
            const int ch0 = 64 * (pn - 16) + 16 * wc + 4 * fq;
#pragma unroll
            for (int ai = 0; ai < 2; ++ai)
#pragma unroll
                for (int m = 0; m < 4; ++m) {
                    const int row = row0 + ai * 128 + m * 16;
                    const f32x4 cc = acc[ai][0][m][0], cx = acc[ai][0][m][1], cb = acc[ai][1][m][0], g = acc[ai][1][m][1];
                    u32x4 w;
                    w.x = cvt_pk_bf16(cc[0] * cx[0], cb[0] * g[0] * sigmoidf_(g[0]));
                    w.y = cvt_pk_bf16(cc[1] * cx[1], cb[1] * g[1] * sigmoidf_(g[1]));
                    w.z = cvt_pk_bf16(cc[2] * cx[2], cb[2] * g[2] * sigmoidf_(g[2]));
                    w.w = cvt_pk_bf16(cc[3] * cx[3], cb[3] * g[3] * sigmoidf_(g[3]));
                    *(u32x4*)(UW + ((size_t)row * 1024 + ch0) * 2) = w;
                }
        } else {
            bf16_t* base = GATE + (pn - 32) * 256 + lc;
#pragma unroll
            for (int ai = 0; ai < 2; ++ai)
#pragma unroll
                for (int m = 0; m < 4; ++m) {
                    const int row = row0 + ai * 128 + m * 16;
#pragma unroll
                    for (int bj = 0; bj < 2; ++bj) {
                        const f32x4 v0 = acc[ai][bj][m][0], v1 = acc[ai][bj][m][1];
                        u32x4 w; w.x = cvt_pk_bf16(sigmoidf_(v0[0]), sigmoidf_(v0[1])); w.y = cvt_pk_bf16(sigmoidf_(v0[2]), sigmoidf_(v0[3]));
                        w.z = cvt_pk_bf16(sigmoidf_(v1[0]), sigmoidf_(v1[1])); w.w = cvt_pk_bf16(sigmoidf_(v1[2]), sigmoidf_(v1[3]));
                        *(u32x4*)(base + (size_t)row * 4096 + bj * 128) = w; }
                }
        }
    }
};

struct Epi2 {
    static constexpr bool PERM = true;
    const bf16_t* GATE; bf16_t* MERGED;
    __device__ __forceinline__ void operator()(const f32x4 (&acc)[2][2][4][2], const pg8::Unit& u, int wr, int wc, int fr, int fq) const {
        const int row0 = u.pm * 256 + wr * 64 + fr, col = u.pn * 256 + wc * 32 + 8 * fq;
#pragma unroll
        for (int ai = 0; ai < 2; ++ai)
#pragma unroll
            for (int m = 0; m < 4; ++m) {
                const int row = row0 + ai * 128 + m * 16;
#pragma unroll
                for (int bj = 0; bj < 2; ++bj) {
                    const u32x4 gw = *(const u32x4*)(GATE + (size_t)row * 4096 + u.z * 2048 + col + bj * 128);
                    const f32x4 v0 = acc[ai][bj][m][0], v1 = acc[ai][bj][m][1];
                    float r[8] = {bf_lo(gw.x) * v0[0], bf_hi(gw.x) * v0[1], bf_lo(gw.y) * v0[2], bf_hi(gw.y) * v0[3],
                                  bf_lo(gw.z) * v1[0], bf_hi(gw.z) * v1[1], bf_lo(gw.w) * v1[2], bf_hi(gw.w) * v1[3]};
                    bf16_t* dst = MERGED + (size_t)row * 2048 + col + bj * 128;
                    if (u.z) { const u32x4 pw = *(const u32x4*)dst;
                        r[0] += bf_lo(pw.x); r[1] += bf_hi(pw.x); r[2] += bf_lo(pw.y); r[3] += bf_hi(pw.y); r[4] += bf_lo(pw.z); r[5] += bf_hi(pw.z); r[6] += bf_lo(pw.w); r[7] += bf_hi(pw.w); }
                    u32x4 w; w.x = cvt_pk_bf16(r[0], r[1]); w.y = cvt_pk_bf16(r[2], r[3]); w.z = cvt_pk_bf16(r[4], r[5]); w.w = cvt_pk_bf16(r[6], r[7]);
                    *(u32x4*)dst = w; }
            }
    }
};

struct Epi3 {
    static constexpr bool PERM = false;
    const float* X; float* OUT; float* SSQ;
    __device__ __forceinline__ void operator()(const f32x4 (&acc)[2][2][4][2], const pg8::Unit& u, int wr, int wc, int fr, int fq) const {
        const int row0 = u.pm * 256 + wr * 64 + fr, col0 = u.pn * 256 + wc * 32 + 4 * fq;
#pragma unroll
        for (int ai = 0; ai < 2; ++ai)
#pragma unroll
            for (int m = 0; m < 4; ++m) {
                const int row = row0 + ai * 128 + m * 16; const size_t off = (size_t)row * 2048 + col0; float ss = 0.f;
#pragma unroll
                for (int bj = 0; bj < 2; ++bj)
#pragma unroll
                    for (int n = 0; n < 2; ++n) { const f32x4 xv = *(const f32x4*)(X + off + bj * 128 + n * 16); const f32x4 y = xv + acc[ai][bj][m][n];
                        *(f32x4*)(OUT + off + bj * 128 + n * 16) = y; ss += (y[0] * y[0] + y[1] * y[1]) + (y[2] * y[2] + y[3] * y[3]); }
                ss += __shfl_xor(ss, 16); ss += __shfl_xor(ss, 32);
                if (fq == 0) SSQ[(size_t)row * 32 + u.pn * 4 + wc] = ss;
            }
    }
};

__device__ __forceinline__ int win_src_col(int c, float& scale) {
    scale = 1.0f;
    if (c < 2048) { const int p = c & 127; if (c >= 1024) scale = 0.08838834764831845f; return (c & ~127) + (p >> 1) + 64 * (p & 1); }
    if (c < 4096 || c >= 8192) return c;
    const int l = (c - 4096) & 255, ct = (c - 4096) >> 8, bj = l >> 7, rem = l & 127, wc = rem >> 5, fq = (rem & 31) >> 3, j8 = rem & 7;
    const int ch = 64 * ct + 16 * wc + 4 * fq + (j8 & 3);
    const int qty = bj == 0 ? (j8 < 4 ? 1 : 2) : (j8 < 4 ? 0 : 3);
    return 4096 + qty * 1024 + ch;
}

__device__ void phase_prologue(const Params& p, LAS unsigned char* lds) {
    const int tid = threadIdx.x, G = gridDim.x;
    unsigned char* ws = p.ws;
    LAS float* tile = (LAS float*)lds;
    for (int tix = blockIdx.x; tix < 8192; tix += G) {
        const float* src; bf16_t* dst; int ld, Kd, n0, k0; bool isin = false;
        if (tix < 6144) { src = p.w_in; dst = (bf16_t*)(ws + WS_WIN); ld = NCOL; Kd = 2048; n0 = (tix >> 5) * 64; k0 = (tix & 31) * 64; isin = true; }
        else if (tix < 7168) { const int t = tix - 6144, z = t >> 9, tt = t & 511; src = p.w_branch + (size_t)z * 1024 * 2048; dst = (bf16_t*)(ws + WS_WB) + (size_t)z * 2048 * 1024; ld = 2048; Kd = 1024; n0 = (tt >> 4) * 64; k0 = (tt & 15) * 64; }
        else { const int t = tix - 7168; src = p.w_out; dst = (bf16_t*)(ws + WS_WO); ld = 2048; Kd = 2048; n0 = (t >> 5) * 64; k0 = (t & 31) * 64; }
        __syncthreads();
        { const int nn = tid & 63, kk0 = tid >> 6; float sc = 1.0f; const int scol = isin ? win_src_col(n0 + nn, sc) : (n0 + nn);
#pragma unroll
          for (int it = 0; it < 8; ++it) { const int kk = kk0 + 8 * it; tile[kk * 65 + nn] = src[(size_t)(k0 + kk) * ld + scol] * sc; } }
        __syncthreads();
        { const int nn = tid >> 3, kq = tid & 7; float v[8];
#pragma unroll
          for (int j = 0; j < 8; ++j) v[j] = tile[(kq * 8 + j) * 65 + nn];
          u32x4 w; w.x = cvt_pk_bf16(v[0], v[1]); w.y = cvt_pk_bf16(v[2], v[3]); w.z = cvt_pk_bf16(v[4], v[5]); w.w = cvt_pk_bf16(v[6], v[7]);
          *(u32x4*)(dst + (size_t)(n0 + nn) * Kd + k0 + kq * 8) = w; }
    }
    {
        float* COS = (float*)(ws + WS_COS); float* SIN = (float*)(ws + WS_SIN);
        for (int idx = blockIdx.x * 512 + tid; idx < SEQ * 64; idx += G * 512) {
            const int pos = idx >> 6, i = idx & 63;
            const float invf = (float)exp2(-(double)i * (13.287712379549449 / 64.0));
            const float angf = (float)pos * invf;
            const double a = (double)angf;
            const double n = rint(a * 0.15915494309189535);
            double r = fma(-n, 6.283185307179586, a); r = fma(-n, 2.4492935982947064e-16, r);
            const double qd = rint(r * 0.6366197723675814); const int q = (int)qd;
            double y = fma(-qd, 1.5707963267948966, r); y = fma(-qd, 6.123233995736766e-17, y);
            const double y2 = y * y;
            double sp = -2.5052108385441720e-08; sp = fma(sp, y2, 2.7557319223985893e-06); sp = fma(sp, y2, -1.9841269841269841e-04); sp = fma(sp, y2, 8.3333333333333332e-03); sp = fma(sp, y2, -1.6666666666666666e-01);
            const double sy = fma(y * y2, sp, y);
            double cp = 2.0876756987868099e-09; cp = fma(cp, y2, -2.7557319223985888e-07); cp = fma(cp, y2, 2.4801587301587302e-05); cp = fma(cp, y2, -1.3888888888888889e-03); cp = fma(cp, y2, 4.1666666666666664e-02); cp = fma(cp, y2, -0.5);
            const double cy = fma(y2, cp, 1.0);
            double s, c;
            switch (q & 3) { case 0: s = sy; c = cy; break; case 1: s = cy; c = -sy; break; case 2: s = -sy; c = -cy; break; default: s = -cy; c = sy; break; }
            COS[idx] = (float)c; SIN[idx] = (float)s;
        }
    }
    {
        bf16_t* H = (bf16_t*)(ws + WS_H); const int lane = tid & 63, wv = tid >> 6;
        for (int row = blockIdx.x * 8 + wv; row < T_TOK; row += G * 8) {
            const float* xr = p.x + (size_t)row * DM; f32x4 v[8]; float ss = 0.f;
#pragma unroll
            for (int i = 0; i < 8; ++i) { v[i] = *(const f32x4*)(xr + i * 256 + lane * 4); ss += (v[i][0] * v[i][0] + v[i][1] * v[i][1]) + (v[i][2] * v[i][2] + v[i][3] * v[i][3]); }
#pragma unroll
            for (int o = 32; o >= 1; o >>= 1) ss += __shfl_xor(ss, o);
            const float rstd = rsqrtf(ss * (1.0f / 2048.0f) + 1e-6f);
#pragma unroll
            for (int i = 0; i < 8; ++i) { const f32x4 g = *(const f32x4*)(p.norm_gain + i * 256 + lane * 4);
                u32x2 w; w.x = cvt_pk_bf16(v[i][0] * rstd * g[0], v[i][1] * rstd * g[1]); w.y = cvt_pk_bf16(v[i][2] * rstd * g[2], v[i][3] * rstd * g[3]);
                *(u32x2*)(H + (size_t)row * DM + i * 256 + lane * 4) = w; }
        }
    }
}

__device__ __forceinline__ void mm128(f32x4 (&acc)[4][2], const LAS bf16_t* At, const LAS bf16_t* Bt, int wr, int wc, int fr, int fq) {
    __builtin_amdgcn_sched_barrier(0);
#pragma unroll 1
    for (int kb = 0; kb < 4; ++kb) {
        bf16x8 a[4], b[2];
#pragma unroll
        for (int m = 0; m < 4; ++m) a[m] = *(const LAS bf16x8*)(At + (64 * wr + 16 * m + fr) * TS + kb * 32 + fq * 8);
#pragma unroll
        for (int n = 0; n < 2; ++n) b[n] = *(const LAS bf16x8*)(Bt + (32 * wc + 16 * n + fr) * TS + kb * 32 + fq * 8);
#pragma unroll
        for (int m = 0; m < 4; ++m)
#pragma unroll
            for (int n = 0; n < 2; ++n) acc[m][n] = __builtin_amdgcn_mfma_f32_16x16x32_bf16(b[n], a[m], acc[m][n], 0, 0, 0);
    }
}
__device__ __forceinline__ void zero_acc(f32x4 (&acc)[4][2]) {
#pragma unroll
    for (int m = 0; m < 4; ++m)
#pragma unroll
        for (int n = 0; n < 2; ++n) acc[m][n] = (f32x4){0.f, 0.f, 0.f, 0.f};
}
__device__ __forceinline__ void stage_nat(LAS bf16_t* dst, const bf16_t* src, size_t ld, int tid) {
#pragma unroll
    for (int it = 0; it < 4; ++it) { const int idx = tid + 512 * it, row = idx >> 4, cg8 = idx & 15;
        const u32x4 v = *(const u32x4*)(src + (size_t)row * ld + cg8 * 8); *(LAS u32x4*)(dst + row * TS + cg8 * 8) = v; }
}

__device__ void phase_r1(const Params& p, LAS unsigned char* lds) {
    const int tid = threadIdx.x, wid = __builtin_amdgcn_readfirstlane(tid >> 6), lane = tid & 63, wr = wid >> 2, wc = wid & 3, fr = lane & 15, fq = lane >> 4;
    LAS bf16_t* VT = (LAS bf16_t*)lds; LAS bf16_t* KfT = VT + 128 * TS; LAS bf16_t* KbT = KfT + 128 * TS;
    const bf16_t* Kg = (const bf16_t*)(p.ws + WS_K); const bf16_t* Vg = (const bf16_t*)(p.ws + WS_V); bf16_t* KV = (bf16_t*)(p.ws + WS_KV);
    for (int unit = blockIdx.x; unit < 2048; unit += gridDim.x) {
        const int bh = unit >> 7, n = unit & 127, b = bh >> 3, h = bh & 7;
        const float lgf = log2_sigmoid(p.lg_f[h]), lgb = log2_sigmoid(p.lg_b[h]);
        const size_t rowbase = (size_t)b * SEQ + (size_t)n * 128;
        __syncthreads();
        { const int s = tid & 127, eg0 = tid >> 7;
          const float wf = exp2f((float)(128 - s) * lgf), wb = exp2f((float)(s + 1) * lgb);
#pragma unroll
          for (int it = 0; it < 4; ++it) { const int eg = eg0 + 4 * it;
              const u32x4 kw = *(const u32x4*)(Kg + (rowbase + s) * 1024 + h * 128 + eg * 8);
              const u32x4 vw = *(const u32x4*)(Vg + (rowbase + s) * 1024 + h * 128 + eg * 8);
              const unsigned kk[4] = {kw.x, kw.y, kw.z, kw.w}, vv[4] = {vw.x, vw.y, vw.z, vw.w};
#pragma unroll
              for (int j = 0; j < 4; ++j) { const float k0 = bf_lo(kk[j]), k1 = bf_hi(kk[j]); const int r0 = (eg * 8 + 2 * j) * TS + s, r1 = r0 + TS;
                  KfT[r0] = f2bf(k0 * wf); KfT[r1] = f2bf(k1 * wf); KbT[r0] = f2bf(k0 * wb); KbT[r1] = f2bf(k1 * wb);
                  VT[r0] = (bf16_t)(vv[j] & 0xffffu); VT[r1] = (bf16_t)(vv[j] >> 16); } } }
        __syncthreads();
#pragma unroll
        for (int dir = 0; dir < 2; ++dir) {
            f32x4 acc[4][2]; zero_acc(acc);
            mm128(acc, VT, dir ? KbT : KfT, wr, wc, fr, fq);
            bf16_t* dst = KV + ((size_t)((dir * 16 + bh) * 128 + n)) * 16384;
#pragma unroll
            for (int m = 0; m < 4; ++m)
#pragma unroll
                for (int nn = 0; nn < 2; ++nn) { const int e = 64 * wr + 16 * m + fr, d = 32 * wc + 16 * nn + 4 * fq;
                    u32x2 w; w.x = cvt_pk_bf16(acc[m][nn][0], acc[m][nn][1]); w.y = cvt_pk_bf16(acc[m][nn][2], acc[m][nn][3]);
                    *(u32x2*)(dst + e * 128 + d) = w; }
        }
    }
}

__device__ void phase_conv(const Params& p) {
    const int tid = threadIdx.x; const int cg4 = tid & 255, half = tid >> 8;
    const unsigned* UW = (const unsigned*)(p.ws + WS_UW); bf16_t* BR1 = (bf16_t*)(p.ws + WS_BR) + (size_t)T_TOK * 1024;
    const f32x4 k0 = *(const f32x4*)(p.conv_w + cg4 * 4), k1 = *(const f32x4*)(p.conv_w + 1024 + cg4 * 4), k2 = *(const f32x4*)(p.conv_w + 2048 + cg4 * 4);
    for (int unit = blockIdx.x; unit < 512; unit += gridDim.x) {
        const int t0 = unit * 64 + half * 32;
        u32x4 prev = (u32x4){0u, 0u, 0u, 0u}, cur, nxt;
        if ((t0 & (SEQ - 1)) != 0) prev = *(const u32x4*)(UW + (size_t)(t0 - 1) * 1024 + cg4 * 4);
        cur = *(const u32x4*)(UW + (size_t)t0 * 1024 + cg4 * 4);
        for (int i = 0; i < 32; ++i) {
            const int t = t0 + i;
            nxt = (u32x4){0u, 0u, 0u, 0u};
            if ((t & (SEQ - 1)) != SEQ - 1) nxt = *(const u32x4*)(UW + (size_t)(t + 1) * 1024 + cg4 * 4);
            const float c0 = k0[0] * bf_lo(prev.x) + k1[0] * bf_lo(cur.x) + k2[0] * bf_lo(nxt.x);
            const float c1 = k0[1] * bf_lo(prev.y) + k1[1] * bf_lo(cur.y) + k2[1] * bf_lo(nxt.y);
            const float c2 = k0[2] * bf_lo(prev.z) + k1[2] * bf_lo(cur.z) + k2[2] * bf_lo(nxt.z);
            const float c3 = k0[3] * bf_lo(prev.w) + k1[3] * bf_lo(cur.w) + k2[3] * bf_lo(nxt.w);
            u32x2 w; w.x = cvt_pk_bf16(c0 * bf_hi(cur.x), c1 * bf_hi(cur.y)); w.y = cvt_pk_bf16(c2 * bf_hi(cur.z), c3 * bf_hi(cur.w));
            *(u32x2*)(BR1 + (size_t)t * 1024 + cg4 * 4) = w;
            prev = cur; cur = nxt;
        }
    }
}

__device__ void phase_scan(const Params& p) {
    const int tid = threadIdx.x;
    const bf16_t* KV = (const bf16_t*)(p.ws + WS_KV); bf16_t* ST = (bf16_t*)(p.ws + WS_ST);
    for (int item = blockIdx.x * 512 + tid; item < 131072; item += gridDim.x * 512) {
        const int q = item & 4095, bh = (item >> 12) & 15, dir = item >> 16, h = bh & 7;
        const float lg = dir ? log2_sigmoid(p.lg_b[h]) : log2_sigmoid(p.lg_f[h]);
        const float a = exp2f(128.0f * lg);
        const size_t base = (size_t)((dir * 16 + bh) * 128) * 16384 + (size_t)q * 4;
        float s0 = 0.f, s1 = 0.f, s2 = 0.f, s3 = 0.f;
        for (int step = 0; step < 128; step += 8) {
            u32x2 kv[8];
#pragma unroll
            for (int j = 0; j < 8; ++j) { const int n = dir ? 127 - (step + j) : (step + j); kv[j] = *(const u32x2*)(KV + base + (size_t)n * 16384); }
#pragma unroll
            for (int j = 0; j < 8; ++j) { const int n = dir ? 127 - (step + j) : (step + j);
                u32x2 w; w.x = cvt_pk_bf16(s0, s1); w.y = cvt_pk_bf16(s2, s3); *(u32x2*)(ST + base + (size_t)n * 16384) = w;
                s0 = a * s0 + bf_lo(kv[j].x); s1 = a * s1 + bf_hi(kv[j].x); s2 = a * s2 + bf_lo(kv[j].y); s3 = a * s3 + bf_hi(kv[j].y); }
        }
    }
}

__device__ void phase_r3(const Params& p, LAS unsigned char* lds) {
    const int tid = threadIdx.x, wid = __builtin_amdgcn_readfirstlane(tid >> 6), lane = tid & 63, wr = wid >> 2, wc = wid & 3, fr = lane & 15, fq = lane >> 4;
    LAS bf16_t* Qs = (LAS bf16_t*)lds; LAS bf16_t* Ks = Qs + 128 * TS; LAS bf16_t* VT = Ks + 128 * TS; LAS bf16_t* Ss = VT + 128 * TS; LAS float* red = (LAS float*)(Ss + 128 * TS);
    const bf16_t* Qg = (const bf16_t*)(p.ws + WS_Q); const bf16_t* Kg = (const bf16_t*)(p.ws + WS_K); const bf16_t* Vg = (const bf16_t*)(p.ws + WS_V);
    const bf16_t* SG = (const bf16_t*)(p.ws + WS_SG); const bf16_t* ST = (const bf16_t*)(p.ws + WS_ST); bf16_t* BR0 = (bf16_t*)(p.ws + WS_BR);
    for (int unit = blockIdx.x; unit < 2048; unit += gridDim.x) {
        const int bh = unit >> 7, n = unit & 127, b = bh >> 3, h = bh & 7;
        const float lgf = log2_sigmoid(p.lg_f[h]), lgb = log2_sigmoid(p.lg_b[h]);
        const size_t rowbase = (size_t)b * SEQ + (size_t)n * 128;
        const bf16_t* Sf = ST + ((size_t)((0 * 16 + bh) * 128 + n)) * 16384; const bf16_t* Sb = ST + ((size_t)((1 * 16 + bh) * 128 + n)) * 16384;
        __syncthreads();
        stage_nat(Qs, Qg + rowbase * 1024 + h * 128, 1024, tid);
        stage_nat(Ks, Kg + rowbase * 1024 + h * 128, 1024, tid);
        stage_nat(Ss, Sf, 128, tid);
        { const int s = tid & 127, eg0 = tid >> 7;
#pragma unroll
          for (int it = 0; it < 4; ++it) { const int eg = eg0 + 4 * it;
              const u32x4 vw = *(const u32x4*)(Vg + (rowbase + s) * 1024 + h * 128 + eg * 8); const unsigned vv[4] = {vw.x, vw.y, vw.z, vw.w};
#pragma unroll
              for (int j = 0; j < 4; ++j) { const int r0 = (eg * 8 + 2 * j) * TS + s; VT[r0] = (bf16_t)(vv[j] & 0xffffu); VT[r0 + TS] = (bf16_t)(vv[j] >> 16); } } }
        __syncthreads();
        f32x4 accP[4][2], acc1[4][2], acc2[4][2];
        zero_acc(accP); mm128(accP, Qs, Ks, wr, wc, fr, fq);
#pragma unroll
        for (int m = 0; m < 4; ++m)
#pragma unroll
            for (int nn = 0; nn < 2; ++nn)
#pragma unroll
                for (int j = 0; j < 4; ++j) { const int t = 64 * wr + 16 * m + fr, s = 32 * wc + 16 * nn + 4 * fq + j; const int df = t - s;
                    accP[m][nn][j] *= (df >= 0) ? exp2f((float)df * lgf) : exp2f((float)(-df) * lgb); }
        zero_acc(acc1); mm128(acc1, Qs, Ss, wr, wc, fr, fq);
#pragma unroll
        for (int m = 0; m < 4; ++m) { const float sc = exp2f((float)(64 * wr + 16 * m + fr) * lgf);
#pragma unroll
            for (int nn = 0; nn < 2; ++nn) acc1[m][nn] *= sc; }
        __syncthreads();
#pragma unroll
        for (int m = 0; m < 4; ++m)
#pragma unroll
            for (int nn = 0; nn < 2; ++nn) { const int t = 64 * wr + 16 * m + fr, s = 32 * wc + 16 * nn + 4 * fq;
                u32x2 w; w.x = cvt_pk_bf16(accP[m][nn][0], accP[m][nn][1]); w.y = cvt_pk_bf16(accP[m][nn][2], accP[m][nn][3]);
                *(LAS u32x2*)(Ks + t * TS + s) = w; }
        stage_nat(Ss, Sb, 128, tid);
        __syncthreads();
        zero_acc(acc2); mm128(acc2, Qs, Ss, wr, wc, fr, fq);
#pragma unroll
        for (int m = 0; m < 4; ++m) { const float sc = exp2f((float)(127 - (64 * wr + 16 * m + fr)) * lgb);
#pragma unroll
            for (int nn = 0; nn < 2; ++nn) acc1[m][nn] += acc2[m][nn] * sc; }
        mm128(acc1, Ks, VT, wr, wc, fr, fq);
#pragma unroll
        for (int m = 0; m < 4; ++m) { float ss = 0.f;
#pragma unroll
            for (int nn = 0; nn < 2; ++nn) ss += (acc1[m][nn][0] * acc1[m][nn][0] + acc1[m][nn][1] * acc1[m][nn][1]) + (acc1[m][nn][2] * acc1[m][nn][2] + acc1[m][nn][3] * acc1[m][nn][3]);
            ss += __shfl_xor(ss, 16); ss += __shfl_xor(ss, 32);
            if (fq == 0) red[(64 * wr + 16 * m + fr) * 4 + wc] = ss; }
        __syncthreads();
#pragma unroll
        for (int m = 0; m < 4; ++m) { const int t = 64 * wr + 16 * m + fr; const f32x4 r4 = *(const LAS f32x4*)(red + t * 4);
            const float rstd = rsqrtf(((r4[0] + r4[1]) + (r4[2] + r4[3])) * (1.0f / 128.0f) + 1e-6f);
#pragma unroll
            for (int nn = 0; nn < 2; ++nn) { const int e0 = 32 * wc + 16 * nn + 4 * fq; const f32x4 gg = *(const f32x4*)(p.gn_gain + h * 128 + e0);
                const u32x2 sg = *(const u32x2*)(SG + (rowbase + t) * 1024 + h * 128 + e0);
                u32x2 w; w.x = cvt_pk_bf16(acc1[m][nn][0] * rstd * gg[0] * bf_lo(sg.x), acc1[m][nn][1] * rstd * gg[1] * bf_hi(sg.x));
                w.y = cvt_pk_bf16(acc1[m][nn][2] * rstd * gg[2] * bf_lo(sg.y), acc1[m][nn][3] * rstd * gg[3] * bf_hi(sg.y));
                *(u32x2*)(BR0 + (rowbase + t) * 1024 + h * 128 + e0) = w; } }
    }
}

__device__ void phase_final(const Params& p) {
    const int tid = threadIdx.x, lane = tid & 63, wv = tid >> 6; const float* SSQ = (const float*)(p.ws + WS_SSQ);
    for (int row = blockIdx.x * 8 + wv; row < T_TOK; row += gridDim.x * 8) {
        float ss = lane < 32 ? SSQ[(size_t)row * 32 + lane] : 0.f;
#pragma unroll
        for (int o = 32; o >= 1; o >>= 1) ss += __shfl_xor(ss, o);
        const float rstd = rsqrtf(ss * (1.0f / 2048.0f) + 1e-6f);
        float* yr = p.out + (size_t)row * DM;
#pragma unroll
        for (int i = 0; i < 8; ++i) { const f32x4 y = *(const f32x4*)(yr + i * 256 + lane * 4), g = *(const f32x4*)(p.final_gain + i * 256 + lane * 4);
            *(f32x4*)(yr + i * 256 + lane * 4) = y * rstd * g; }
    }
}

__device__ __forceinline__ void grid_barrier(cg::grid_group& grid) {
    asm volatile("s_waitcnt vmcnt(0) lgkmcnt(0)" ::: "memory");
    __builtin_amdgcn_fence(__ATOMIC_RELEASE, "agent");
    asm volatile("s_waitcnt vmcnt(0)" ::: "memory");
    grid.sync();
    __builtin_amdgcn_fence(__ATOMIC_ACQUIRE, "agent");
    asm volatile("s_waitcnt vmcnt(0)" ::: "memory");
}

__global__ void __launch_bounds__(512, 2) fwd_megakernel(Params p) {
    extern __shared__ __attribute__((aligned(16))) unsigned char lds_raw[];
    LAS unsigned char* lds = (LAS unsigned char*)lds_raw;
    cg::grid_group grid = cg::this_grid();
    unsigned char* ws = p.ws;
    const int G = gridDim.x, c = blockIdx.x;

#ifndef PHM
#define PHM 255
#endif
    if (PHM & 1) phase_prologue(p, lds);
    grid_barrier(grid);
    if (PHM & 2) {
        pg8::Gemm g{(const bf16_t*)(ws + WS_H), (const bf16_t*)(ws + WS_WIN), T_TOK, NCOL, 2048, 0, 0};
        pg8::Order S; S.init(T_TOK, NCOL, G, c, 0);
        Epi1 E{(bf16_t*)(ws + WS_Q), (bf16_t*)(ws + WS_K), (bf16_t*)(ws + WS_V), (bf16_t*)(ws + WS_SG), (bf16_t*)(ws + WS_UW), (bf16_t*)(ws + WS_GATE), (const float*)(ws + WS_COS), (const float*)(ws + WS_SIN)};
        pg8::gemm_phase<Epi1>(lds, g, S, E);
    }
    grid_barrier(grid);
    if (PHM & 4) phase_r1(p, lds);
    if (PHM & 4) phase_conv(p);
    grid_barrier(grid);
    if (PHM & 8) phase_scan(p);
    grid_barrier(grid);
    if (PHM & 16) phase_r3(p, lds);
    grid_barrier(grid);
    if (PHM & 32) {
        pg8::Gemm g{(const bf16_t*)(ws + WS_BR), (const bf16_t*)(ws + WS_WB), T_TOK, 2048, 1024, (size_t)T_TOK * 1024 * 2, (size_t)2048 * 1024 * 2};
        pg8::Order S; S.init(T_TOK, 2048, G, c, 1);
        Epi2 E{(const bf16_t*)(ws + WS_GATE), (bf16_t*)(ws + WS_MERGED)};
        pg8::gemm_phase<Epi2>(lds, g, S, E);
    }
    grid_barrier(grid);
    if (PHM & 64) {
        pg8::Gemm g{(const bf16_t*)(ws + WS_MERGED), (const bf16_t*)(ws + WS_WO), T_TOK, 2048, 2048, 0, 0};
        pg8::Order S; S.init(T_TOK, 2048, G, c, 0);
        Epi3 E{p.x, p.out, (float*)(ws + WS_SSQ)};
        pg8::gemm_phase<Epi3>(lds, g, S, E);
    }
    grid_barrier(grid);
    if (PHM & 128) phase_final(p);
}

extern "C" void kernel_launch(void* const* d_in, const int* in_sizes, int n_in, void* d_out, int out_size, void* d_ws, size_t ws_size, hipStream_t stream) {
    static int grid_blocks = 0;
    if (!grid_blocks) {
        if (n_in != 10 || out_size != T_TOK * DM || ws_size < WS_END) { fprintf(stderr, "kernel_launch: unexpected shapes (n_in %d out %d ws %zu)\n", n_in, out_size, ws_size); grid_blocks = -1; return; }
        int dev = 0, cus = 0, per_cu = 0;
        hipGetDevice(&dev);
        hipDeviceGetAttribute(&cus, hipDeviceAttributeMultiprocessorCount, dev);
        if (hipFuncSetAttribute((const void*)fwd_megakernel, hipFuncAttributeMaxDynamicSharedMemorySize, LDS_BYTES) != hipSuccess) { fprintf(stderr, "kernel_launch: hipFuncSetAttribute failed\n"); grid_blocks = -1; return; }
        hipOccupancyMaxActiveBlocksPerMultiprocessor(&per_cu, (const void*)fwd_megakernel, 512, LDS_BYTES);
        if (per_cu < 1) { fprintf(stderr, "kernel_launch: occupancy query says %d blocks per CU\n", per_cu); per_cu = 1; }
        grid_blocks = cus * per_cu;
    }
    if (grid_blocks < 0) return;
    Params p{};
    p.x = (const float*)d_in[0]; p.norm_gain = (const float*)d_in[1]; p.w_in = (const float*)d_in[2]; p.lg_f = (const float*)d_in[3]; p.lg_b = (const float*)d_in[4];
    p.gn_gain = (const float*)d_in[5]; p.conv_w = (const float*)d_in[6]; p.w_branch = (const float*)d_in[7]; p.w_out = (const float*)d_in[8]; p.final_gain = (const float*)d_in[9];
    p.out = (float*)d_out; p.ws = (unsigned char*)d_ws;
    void* args[] = {&p};
    hipError_t e = hipLaunchCooperativeKernel((const void*)fwd_megakernel, dim3(grid_blocks), dim3(512), args, LDS_BYTES, stream);
    if (e != hipSuccess) fprintf(stderr, "cooperative launch failed: %s (grid %d)\n", hipGetErrorString(e), grid_blocks);
}
```

```cpp
#include <hip/hip_runtime.h>
#include <hip/hip_cooperative_groups.h>
#include <cstdio>
namespace cg = cooperative_groups;

#define LAS __attribute__((address_space(3)))
typedef unsigned short bf16_t;
typedef short bf16x8 __attribute__((ext_vector_type(8)));
typedef float f32x4 __attribute__((ext_vector_type(4)));
typedef unsigned u32x4 __attribute__((ext_vector_type(4)));
typedef unsigned u32x2 __attribute__((ext_vector_type(2)));

constexpr int T_TOK = 32768, DM = 2048, SEQ = 16384, NCOL = 12288;
constexpr size_t MiB = 1ull << 20;
constexpr size_t WS_H = 0, WS_KV = 0, WS_WIN = 128 * MiB, WS_WB = 176 * MiB, WS_WO = 184 * MiB, WS_COS = 192 * MiB, WS_SIN = 196 * MiB,
                 WS_Q = 200 * MiB, WS_K = 264 * MiB, WS_MERGED = 200 * MiB, WS_V = 328 * MiB, WS_SG = 392 * MiB, WS_UW = 456 * MiB, WS_ST = 456 * MiB,
                 WS_GATE = 584 * MiB, WS_BR = 840 * MiB, WS_SSQ = 968 * MiB, WS_END = 972 * MiB;
constexpr int LDS_BYTES = 147456;
constexpr int TS = 136;

struct Params {
    const float* x; const float* norm_gain; const float* w_in; const float* lg_f; const float* lg_b; const float* gn_gain;
    const float* conv_w; const float* w_branch; const float* w_out; const float* final_gain; float* out; unsigned char* ws;
};

typedef __bf16 bf16x2_t __attribute__((ext_vector_type(2)));
typedef float f32x2_t __attribute__((ext_vector_type(2)));
__device__ __forceinline__ unsigned cvt_pk_bf16(float lo, float hi) { f32x2_t v = {lo, hi}; bf16x2_t b = __builtin_convertvector(v, bf16x2_t); return __builtin_bit_cast(unsigned, b); }
__device__ __forceinline__ bf16_t f2bf(float f) { unsigned u = __float_as_uint(f); u += 0x7FFFu + ((u >> 16) & 1u); return (bf16_t)(u >> 16); }
__device__ __forceinline__ float bf_lo(unsigned w) { return __uint_as_float(w << 16); }
__device__ __forceinline__ float bf_hi(unsigned w) { return __uint_as_float(w & 0xffff0000u); }
__device__ __forceinline__ float sigmoidf_(float x) { return __builtin_amdgcn_rcpf(1.0f + __expf(-x)); }
__device__ __forceinline__ float log2_sigmoid(float x) { return -log1pf(expf(-x)) * 1.4426950408889634f; }

namespace pg8 {
constexpr int BM = 256, BK = 64, HALF = 128, HTB = HALF * BK * 2, STAGE_BYTES = 8 * HTB, NXCD = 8, WGM = 8;
__host__ __device__ __forceinline__ int lds_byte(int r, int c) { const int st = (r >> 4) * 2 + (c >> 5), rr = r & 15, cc = c & 31, ob = rr * 64 + cc * 2; return st * 1024 + (ob ^ (((ob >> 9) & 1) << 5)); }
__host__ __device__ __forceinline__ void stage_rc(int b, int& R, int& C) { const int st = b / 1024, sb = b % 1024, swz = sb ^ (((sb >> 9) & 1) << 5); R = (st >> 1) * 16 + swz / 64; C = (st & 1) * 32 + (swz % 64) / 2; }
__host__ __device__ __forceinline__ int perm32(int rho) { const int n = rho >> 4, i = rho & 15; return 8 * (i >> 2) + 4 * n + (i & 3); }

struct Unit { int pm, pn, z; };
struct Gemm { const bf16_t* A; const bf16_t* Bt; int M, N, K; size_t zA, zB; };

struct Order {
    int nM, nN, nwg, G, c, zsh;
    __device__ void init(int M, int N, int G_, int c_, int zsh_) { nM = M / BM; nN = N / BM; nwg = nM * nN; G = G_; c = c_; zsh = zsh_; }
    __device__ bool next(int i, Unit& u) const {
        const int ti = i >> zsh; u.z = i & ((1 << zsh) - 1);
        const long L = (long)ti * G + c; if (L >= nwg) return false;
        int wgid = (int)L; { const int q = nwg / NXCD, r = nwg % NXCD, xcd = wgid % NXCD, off = wgid / NXCD; wgid = (xcd < r ? xcd * (q + 1) : r * (q + 1) + (xcd - r) * q) + off; }
        const int nig = WGM * nN, gid = wgid / nig, fm = gid * WGM, gsz = (nM - fm) < WGM ? (nM - fm) : WGM;
        u.pm = fm + ((wgid % nig) % gsz); u.pn = (wgid % nig) / gsz; return true;
    }
};

template <class Epi>
__device__ __forceinline__ void gemm_phase(LAS unsigned char* lds, const Gemm g, const Order& S, const Epi& E) {
    const int tid = threadIdx.x, wid = __builtin_amdgcn_readfirstlane(tid >> 6), lane = tid & 63, wr = wid >> 2, wc = wid & 3, fr = lane & 15, fq = lane >> 4;
    const int K = g.K, nt = K / BK;
    unsigned voffA[2], voffB[2];
#pragma unroll
    for (int i = 0; i < 2; ++i) { int R, C; stage_rc(tid * 16 + i * 8192, R, C); const int Rb = Epi::PERM ? ((R & ~31) + perm32(R & 31)) : R;
        voffA[i] = (unsigned)(R * K + C) * 2u; voffB[i] = (unsigned)(Rb * K + C) * 2u; }
    const size_t kstep = (size_t)(BK * 2);
    const size_t hstep = (size_t)HALF * K * 2;
    const size_t tstep = 2 * hstep;
    const unsigned ldsw = (unsigned)wid * 1024u;
    const int aoff = lds_byte(wr * 64 + fr, fq * 8), boff = lds_byte(wc * 32 + fr, fq * 8);
#define PG8_SA(b, h) (((b) * 2 + (h)) * HTB)
#define PG8_SB(b, h) ((4 + (b) * 2 + (h)) * HTB)
#define PG8_STAGE(bufoff, gbase, voff) do { _Pragma("unroll") for (int _i = 0; _i < 2; ++_i) \
        __builtin_amdgcn_global_load_lds((const unsigned*)((const char*)(gbase) + (voff)[_i]), (LAS unsigned*)(lds + (bufoff) + ldsw + _i * 8192), 16, 0, 0); } while (0)
#define PG8_LDA(dst, b, h) do { _Pragma("unroll") for (int m = 0; m < 4; ++m) _Pragma("unroll") for (int k = 0; k < 2; ++k) dst[m][k] = *(const LAS bf16x8*)(lds + PG8_SA(b, h) + aoff + m * 2048 + k * 1024); } while (0)
#define PG8_LDB(dst, b, h) do { _Pragma("unroll") for (int n = 0; n < 2; ++n) _Pragma("unroll") for (int k = 0; k < 2; ++k) dst[n][k] = *(const LAS bf16x8*)(lds + PG8_SB(b, h) + boff + n * 2048 + k * 1024); } while (0)
#define PG8_MMA(ai, bj, At, Bt) do { __builtin_amdgcn_s_setprio(1); _Pragma("unroll") for (int m = 0; m < 4; ++m) _Pragma("unroll") for (int n = 0; n < 2; ++n) _Pragma("unroll") for (int k = 0; k < 2; ++k) \
        acc[ai][bj][m][n] = __builtin_amdgcn_mfma_f32_16x16x32_bf16(Bt[n][k], At[m][k], acc[ai][bj][m][n], 0, 0, 0); __builtin_amdgcn_s_setprio(0); } while (0)
#define PG8_WAIT_V(n) asm volatile("s_waitcnt vmcnt(" #n ")" ::: "memory")
#define PG8_WAIT_L(n) asm volatile("s_waitcnt lgkmcnt(" #n ")" ::: "memory")
#define PG8_BAR __builtin_amdgcn_s_barrier()
#define PG8_SCHED __builtin_amdgcn_sched_barrier(0)
    Unit cur, nxt; int ui = 0;
    if (!S.next(0, cur)) return;
    f32x4 acc[2][2][4][2];
#pragma unroll
    for (int a = 0; a < 2; ++a)
#pragma unroll
        for (int b = 0; b < 2; ++b)
#pragma unroll
            for (int m = 0; m < 4; ++m)
#pragma unroll
                for (int n = 0; n < 2; ++n) acc[a][b][m][n] = (f32x4){0.f, 0.f, 0.f, 0.f};
    bf16x8 At[4][2], B0[2][2], B1[2][2];
    const char* cA = (const char*)g.A + (size_t)cur.pm * tstep + (size_t)cur.z * g.zA; const char* cB = (const char*)g.Bt + (size_t)cur.pn * tstep + (size_t)cur.z * g.zB;
    PG8_STAGE(PG8_SB(0, 0), cB, voffB); PG8_STAGE(PG8_SA(0, 0), cA, voffA); PG8_STAGE(PG8_SB(0, 1), cB + hstep, voffB); PG8_STAGE(PG8_SA(0, 1), cA + hstep, voffA);
    if (wr == 1) PG8_BAR;
    PG8_WAIT_V(4); PG8_BAR;
    PG8_STAGE(PG8_SB(1, 0), cB + kstep, voffB); PG8_STAGE(PG8_SA(1, 0), cA + kstep, voffA); PG8_STAGE(PG8_SB(1, 1), cB + hstep + kstep, voffB);
    PG8_WAIT_V(6); PG8_BAR;
    for (;;) {
        const bool has_next = S.next(ui + 1, nxt);
        const char* nA = has_next ? (const char*)g.A + (size_t)nxt.pm * tstep + (size_t)nxt.z * g.zA : cA;
        const char* nB = has_next ? (const char*)g.Bt + (size_t)nxt.pn * tstep + (size_t)nxt.z * g.zB : cB;
        for (int t = 0; t < nt; t += 2) {
            const bool last = (t == nt - 2);
            const char* a1 = cA + (size_t)(t + 1) * kstep;
            const char* a2 = last ? nA : cA + (size_t)(t + 2) * kstep; const char* b2 = last ? nB : cB + (size_t)(t + 2) * kstep;
            const char* a3 = a2 + kstep; const char* b3 = b2 + kstep;
            PG8_LDB(B0, 0, 0); PG8_SCHED; PG8_LDA(At, 0, 0); PG8_STAGE(PG8_SA(1, 1), a1 + hstep, voffA);
            PG8_WAIT_L(8); PG8_BAR; PG8_WAIT_L(0); PG8_MMA(0, 0, At, B0); PG8_BAR; PG8_SCHED;
            PG8_LDB(B1, 0, 1); PG8_STAGE(PG8_SB(0, 0), b2, voffB);
            PG8_BAR; PG8_WAIT_L(0); PG8_MMA(0, 1, At, B1); PG8_BAR;
            PG8_LDA(At, 0, 1); PG8_STAGE(PG8_SA(0, 0), a2, voffA);
            PG8_BAR; PG8_WAIT_L(0); PG8_MMA(1, 0, At, B0); PG8_BAR; PG8_SCHED;
            PG8_STAGE(PG8_SB(0, 1), b2 + hstep, voffB);
            PG8_WAIT_V(6); PG8_BAR; PG8_MMA(1, 1, At, B1); PG8_BAR;
            PG8_LDB(B0, 1, 0); PG8_SCHED; PG8_LDA(At, 1, 0); PG8_STAGE(PG8_SA(0, 1), a2 + hstep, voffA);
            PG8_WAIT_L(8); PG8_BAR; PG8_WAIT_L(0); PG8_MMA(0, 0, At, B0); PG8_BAR; PG8_SCHED;
            PG8_LDB(B1, 1, 1); PG8_STAGE(PG8_SB(1, 0), b3, voffB);
            PG8_BAR; PG8_WAIT_L(0); PG8_MMA(0, 1, At, B1); PG8_BAR;
            PG8_LDA(At, 1, 1); PG8_STAGE(PG8_SA(1, 0), a3, voffA);
            PG8_BAR; PG8_WAIT_L(0); PG8_MMA(1, 0, At, B0); PG8_BAR; PG8_SCHED;
            PG8_STAGE(PG8_SB(1, 1), b3 + hstep, voffB);
            PG8_WAIT_V(6); PG8_BAR; PG8_MMA(1, 1, At, B1); PG8_BAR;
        }
        E(acc, cur, wr, wc, fr, fq);
        if (!has_next) break;
#pragma unroll
        for (int a = 0; a < 2; ++a)
#pragma unroll
            for (int b = 0; b < 2; ++b)
#pragma unroll
                for (int m = 0; m < 4; ++m)
#pragma unroll
                    for (int n = 0; n < 2; ++n) acc[a][b][m][n] = (f32x4){0.f, 0.f, 0.f, 0.f};
        cur = nxt; cA = nA; cB = nB; ++ui;
    }
    PG8_WAIT_V(0);
    if (wr == 0) PG8_BAR;
    PG8_BAR;
#undef PG8_SA
#undef PG8_SB
#undef PG8_STAGE
#undef PG8_LDA
#undef PG8_LDB
#undef PG8_MMA
#undef PG8_WAIT_V
#undef PG8_WAIT_L
#undef PG8_BAR
#undef PG8_SCHED
}
}

struct Epi1 {
    static constexpr bool PERM = true;
    bf16_t *Q, *K, *V, *SG, *UW, *GATE; const float *COS, *SIN;
    __device__ __forceinline__ void operator()(const f32x4 (&acc)[2][2][4][2], const pg8::Unit& u, int wr, int wc, int fr, int fq) const {
        const int row0 = u.pm * 256 + wr * 64 + fr, lc = wc * 32 + 8 * fq, pn = u.pn;
        if (pn < 8) {
            bf16_t* base = (pn < 4 ? Q : K) + (pn & 3) * 256 + lc;
            const int i0 = lc >> 1;
#pragma unroll
            for (int ai = 0; ai < 2; ++ai) {
                f32x4 cs[4], sn[4];
#pragma unroll
                for (int m = 0; m < 4; ++m) { const int pos = (row0 + ai * 128 + m * 16) & (SEQ - 1);
                    cs[m] = *(const f32x4*)(COS + pos * 64 + i0); sn[m] = *(const f32x4*)(SIN + pos * 64 + i0); }
#pragma unroll
                for (int m = 0; m < 4; ++m) {
                    const int row = row0 + ai * 128 + m * 16;
#pragma unroll
                    for (int bj = 0; bj < 2; ++bj) {
                        const f32x4 v0 = acc[ai][bj][m][0], v1 = acc[ai][bj][m][1]; u32x4 w;
                        w.x = cvt_pk_bf16(v0[0] * cs[m][0] - v0[1] * sn[m][0], v0[1] * cs[m][0] + v0[0] * sn[m][0]);
                        w.y = cvt_pk_bf16(v0[2] * cs[m][1] - v0[3] * sn[m][1], v0[3] * cs[m][1] + v0[2] * sn[m][1]);
                        w.z = cvt_pk_bf16(v1[0] * cs[m][2] - v1[1] * sn[m][2], v1[1] * cs[m][2] + v1[0] * sn[m][2]);
                        w.w = cvt_pk_bf16(v1[2] * cs[m][3] - v1[3] * sn[m][3], v1[3] * cs[m][3] + v1[2] * sn[m][3]);
                        *(u32x4*)(base + (size_t)row * 1024 + bj * 128) = w; }
                }
            }
        } else if (pn < 16) {
            const bool act = pn >= 12;
            bf16_t* base = (act ? SG : V) + (pn & 3) * 256 + lc;
#pragma unroll
            for (int ai = 0; ai < 2; ++ai)
#pragma unroll
                for (int m = 0; m < 4; ++m) {
                    const int row = row0 + ai * 128 + m * 16;
#pragma unroll
                    for (int bj = 0; bj < 2; ++bj) {
                        f32x4 v0 = acc[ai][bj][m][0], v1 = acc[ai][bj][m][1];
                        if (act) {
#pragma unroll
                            for (int j = 0; j < 4; ++j) { v0[j] = v0[j] * sigmoidf_(v0[j]); v1[j] = v1[j] * sigmoidf_(v1[j]); } }
                        u32x4 w; w.x = cvt_pk_bf16(v0[0], v0[1]); w.y = cvt_pk_bf16(v0[2], v0[3]); w.z = cvt_pk_bf16(v1[0], v1[1]); w.w = cvt_pk_bf16(v1[2], v1[3]);
                        *(u32x4*)(base + (size_t)row * 1024 + bj * 128) = w; }
                }
        } else if (pn < 32) {
            const int ch0 = 64 * (pn - 16) + 16 * wc + 4 * fq;
#pragma unroll
            for (int ai = 0; ai < 2; ++ai)
#pragma unroll
                for (int m = 0; m < 4; ++m) {
                    const int row = row0 + ai * 128 + m * 16;
                    const f32x4 cc = acc[ai][0][m][0], cx = acc[ai][0][m][1], cb = acc[ai][1][m][0], g = acc[ai][1][m][1];
                    u32x4 w;
                    w.x = cvt_pk_bf16(cc[0] * cx[0], cb[0] * g[0] * sigmoidf_(g[0]));
                    w.y = cvt_pk_bf16(cc[1] * cx[1], cb[1] * g[1] * sigmoidf_(g[1]));
                    w.z = cvt_pk_bf16(cc[2] * cx[2], cb[2] * g[2] * sigmoidf_(g[2]));
                    w.w = cvt_pk_bf16(cc[3] * cx[3], cb[3] * g[3] * sigmoidf_(g[3]));
                    *(u32x4*)(UW + ((size_t)row * 1024 + ch0) * 2) = w;
                }
        } else {
            bf16_t* base = GATE + (pn - 32) * 256 + lc;
#pragma unroll
            for (int ai = 0; ai < 2; ++ai)
#pragma unroll
                for (int m = 0; m < 4; ++m) {
                    const int row = row0 + ai * 128 + m * 16;
#pragma unroll
                    for (int bj = 0; bj < 2; ++bj) {
                        const f32x4 v0 = acc[ai][bj][m][0], v1 = acc[ai][bj][m][1];
                        u32x4 w; w.x = cvt_pk_bf16(sigmoidf_(v0[0]), sigmoidf_(v0[1])); w.y = cvt_pk_bf16(sigmoidf_(v0[2]), sigmoidf_(v0[3]));
                        w.z = cvt_pk_bf16(sigmoidf_(v1[0]), sigmoidf_(v1[1])); w.w = cvt_pk_bf16(sigmoidf_(v1[2]), sigmoidf_(v1[3]));
                        *(u32x4*)(base + (size_t)row * 4096 + bj * 128) = w; }
                }
        }
    }
};

struct Epi2 {
    static constexpr bool PERM = true;
    const bf16_t* GATE; bf16_t* MERGED;
    __device__ __forceinline__ void operator()(const f32x4 (&acc)[2][2][4][2], const pg8::Unit& u, int wr, int wc, int fr, int fq) const {
        const int row0 = u.pm * 256 + wr * 64 + fr, col = u.pn * 256 + wc * 32 + 8 * fq;
#pragma unroll
        for (int ai = 0; ai < 2; ++ai) {
            u32x4 gw[4][2], pw[4][2];
#pragma unroll
            for (int m = 0; m < 4; ++m)
#pragma unroll
                for (int bj = 0; bj < 2; ++bj) { const int row = row0 + ai * 128 + m * 16;
                    gw[m][bj] = *(const u32x4*)(GATE + (size_t)row * 4096 + u.z * 2048 + col + bj * 128);
                    pw[m][bj] = u.z ? *(const u32x4*)(MERGED + (size_t)row * 2048 + col + bj * 128) : (u32x4){0u, 0u, 0u, 0u}; }
#pragma unroll
            for (int m = 0; m < 4; ++m)
#pragma unroll
                for (int bj = 0; bj < 2; ++bj) { const int row = row0 + ai * 128 + m * 16;
                    const u32x4 g = gw[m][bj], pv = pw[m][bj]; const f32x4 v0 = acc[ai][bj][m][0], v1 = acc[ai][bj][m][1];
                    u32x4 w;
                    w.x = cvt_pk_bf16(bf_lo(g.x) * v0[0] + bf_lo(pv.x), bf_hi(g.x) * v0[1] + bf_hi(pv.x));
                    w.y = cvt_pk_bf16(bf_lo(g.y) * v0[2] + bf_lo(pv.y), bf_hi(g.y) * v0[3] + bf_hi(pv.y));
                    w.z = cvt_pk_bf16(bf_lo(g.z) * v1[0] + bf_lo(pv.z), bf_hi(g.z) * v1[1] + bf_hi(pv.z));
                    w.w = cvt_pk_bf16(bf_lo(g.w) * v1[2] + bf_lo(pv.w), bf_hi(g.w) * v1[3] + bf_hi(pv.w));
                    *(u32x4*)(MERGED + (size_t)row * 2048 + col + bj * 128) = w; }
        }
    }
};

struct Epi3 {
    static constexpr bool PERM = false;
    const float* X; float* OUT; float* SSQ;
    __device__ __forceinline__ void operator()(const f32x4 (&acc)[2][2][4][2], const pg8::Unit& u, int wr, int wc, int fr, int fq) const {
        const int row0 = u.pm * 256 + wr * 64 + fr, col0 = u.pn * 256 + wc * 32 + 4 * fq;
#pragma unroll
        for (int ai = 0; ai < 2; ++ai) {
            f32x4 xv[4][2][2];
#pragma unroll
            for (int m = 0; m < 4; ++m)
#pragma unroll
                for (int bj = 0; bj < 2; ++bj)
#pragma unroll
                    for (int n = 0; n < 2; ++n) xv[m][bj][n] = *(const f32x4*)(X + (size_t)(row0 + ai * 128 + m * 16) * 2048 + col0 + bj * 128 + n * 16);
#pragma unroll
            for (int m = 0; m < 4; ++m) {
                const int row = row0 + ai * 128 + m * 16; const size_t off = (size_t)row * 2048 + col0; float ss = 0.f;
#pragma unroll
                for (int bj = 0; bj < 2; ++bj)
#pragma unroll
                    for (int n = 0; n < 2; ++n) { const f32x4 y = xv[m][bj][n] + acc[ai][bj][m][n];
                        *(f32x4*)(OUT + off + bj * 128 + n * 16) = y; ss += (y[0] * y[0] + y[1] * y[1]) + (y[2] * y[2] + y[3] * y[3]); }
                ss += __shfl_xor(ss, 16); ss += __shfl_xor(ss, 32);
                if (fq == 0) SSQ[(size_t)row * 32 + u.pn * 4 + wc] = ss;
            }
        }
    }
};

__device__ __forceinline__ int win_src_col(int c, float& scale) {
    scale = 1.0f;
    if (c < 2048) { const int p = c & 127; if (c >= 1024) scale = 0.08838834764831845f; return (c & ~127) + (p >> 1) + 64 * (p & 1); }
    if (c < 4096 || c >= 8192) return c;
    const int l = (c - 4096) & 255, ct = (c - 4096) >> 8, bj = l >> 7, rem = l & 127, wc = rem >> 5, fq = (rem & 31) >> 3, j8 = rem & 7;
    const int ch = 64 * ct + 16 * wc + 4 * fq + (j8 & 3);
    const int qty = bj == 0 ? (j8 < 4 ? 1 : 2) : (j8 < 4 ? 0 : 3);
    return 4096 + qty * 1024 + ch;
}

__device__ void phase_prologue(const Params& p, LAS unsigned char* lds) {
    const int tid = threadIdx.x, G = gridDim.x;
    unsigned char* ws = p.ws;
    LAS float* tile = (LAS float*)lds;
    for (int tix = blockIdx.x; tix < 8192; tix += G) {
        const float* src; bf16_t* dst; int ld, Kd, n0, k0; bool isin = false;
        if (tix < 6144) { src = p.w_in; dst = (bf16_t*)(ws + WS_WIN); ld = NCOL; Kd = 2048; n0 = (tix >> 5) * 64; k0 = (tix & 31) * 64; isin = true; }
        else if (tix < 7168) { const int t = tix - 6144, z = t >> 9, tt = t & 511; src = p.w_branch + (size_t)z * 1024 * 2048; dst = (bf16_t*)(ws + WS_WB) + (size_t)z * 2048 * 1024; ld = 2048; Kd = 1024; n0 = (tt >> 4) * 64; k0 = (tt & 15) * 64; }
        else { const int t = tix - 7168; src = p.w_out; dst = (bf16_t*)(ws + WS_WO); ld = 2048; Kd = 2048; n0 = (t >> 5) * 64; k0 = (t & 31) * 64; }
        __syncthreads();
        { const int nn = tid & 63, kk0 = tid >> 6; float sc = 1.0f; const int scol = isin ? win_src_col(n0 + nn, sc) : (n0 + nn);
#pragma unroll
          for (int it = 0; it < 8; ++it) { const int kk = kk0 + 8 * it; tile[kk * 65 + nn] = src[(size_t)(k0 + kk) * ld + scol] * sc; } }
        __syncthreads();
        { const int nn = tid >> 3, kq = tid & 7; float v[8];
#pragma unroll
          for (int j = 0; j < 8; ++j) v[j] = tile[(kq * 8 + j) * 65 + nn];
          u32x4 w; w.x = cvt_pk_bf16(v[0], v[1]); w.y = cvt_pk_bf16(v[2], v[3]); w.z = cvt_pk_bf16(v[4], v[5]); w.w = cvt_pk_bf16(v[6], v[7]);
          *(u32x4*)(dst + (size_t)(n0 + nn) * Kd + k0 + kq * 8) = w; }
    }
    {
        float* COS = (float*)(ws + WS_COS); float* SIN = (float*)(ws + WS_SIN);
        for (int idx = blockIdx.x * 512 + tid; idx < SEQ * 64; idx += G * 512) {
            const int pos = idx >> 6, i = idx & 63;
            const float invf = (float)exp2(-(double)i * (13.287712379549449 / 64.0));
            const float angf = (float)pos * invf;
            const double a = (double)angf;
            const double n = rint(a * 0.15915494309189535);
            double r = fma(-n, 6.283185307179586, a); r = fma(-n, 2.4492935982947064e-16, r);
            const double qd = rint(r * 0.6366197723675814); const int q = (int)qd;
            double y = fma(-qd, 1.5707963267948966, r); y = fma(-qd, 6.123233995736766e-17, y);
            const double y2 = y * y;
            double sp = -2.5052108385441720e-08; sp = fma(sp, y2, 2.7557319223985893e-06); sp = fma(sp, y2, -1.9841269841269841e-04); sp = fma(sp, y2, 8.3333333333333332e-03); sp = fma(sp, y2, -1.6666666666666666e-01);
            const double sy = fma(y * y2, sp, y);
            double cp = 2.0876756987868099e-09; cp = fma(cp, y2, -2.7557319223985888e-07); cp = fma(cp, y2, 2.4801587301587302e-05); cp = fma(cp, y2, -1.3888888888888889e-03); cp = fma(cp, y2, 4.1666666666666664e-02); cp = fma(cp, y2, -0.5);
            const double cy = fma(y2, cp, 1.0);
            double s, c;
            switch (q & 3) { case 0: s = sy; c = cy; break; case 1: s = cy; c = -sy; break; case 2: s = -sy; c = -cy; break; default: s = -cy; c = sy; break; }
            COS[idx] = (float)c; SIN[idx] = (float)s;
        }
    }
    {
        bf16_t* H = (bf16_t*)(ws + WS_H); const int lane = tid & 63, wv = tid >> 6;
        for (int row = blockIdx.x * 8 + wv; row < T_TOK; row += G * 8) {
            const float* xr = p.x + (size_t)row * DM; f32x4 v[8]; float ss = 0.f;
#pragma unroll
            for (int i = 0; i < 8; ++i) { v[i] = *(const f32x4*)(xr + i * 256 + lane * 4); ss += (v[i][0] * v[i][0] + v[i][1] * v[i][1]) + (v[i][2] * v[i][2] + v[i][3] * v[i][3]); }
#pragma unroll
            for (int o = 32; o >= 1; o >>= 1) ss += __shfl_xor(ss, o);
            const float rstd = rsqrtf(ss * (1.0f / 2048.0f) + 1e-6f);
#pragma unroll
            for (int i = 0; i < 8; ++i) { const f32x4 g = *(const f32x4*)(p.norm_gain + i * 256 + lane * 4);
                u32x2 w; w.x = cvt_pk_bf16(v[i][0] * rstd * g[0], v[i][1] * rstd * g[1]); w.y = cvt_pk_bf16(v[i][2] * rstd * g[2], v[i][3] * rstd * g[3]);
                *(u32x2*)(H + (size_t)row * DM + i * 256 + lane * 4) = w; }
        }
    }
}

__device__ __forceinline__ void mm128(f32x4 (&acc)[4][2], const LAS bf16_t* At, const LAS bf16_t* Bt, int wr, int wc, int fr, int fq) {
    __builtin_amdgcn_sched_barrier(0);
#pragma unroll 1
    for (int kb = 0; kb < 4; ++kb) {
        bf16x8 a[4], b[2];
#pragma unroll
        for (int m = 0; m < 4; ++m) a[m] = *(const LAS bf16x8*)(At + (64 * wr + 16 * m + fr) * TS + kb * 32 + fq * 8);
#pragma unroll
        for (int n = 0; n < 2; ++n) b[n] = *(const LAS bf16x8*)(Bt + (32 * wc + 16 * n + fr) * TS + kb * 32 + fq * 8);
#pragma unroll
        for (int m = 0; m < 4; ++m)
#pragma unroll
            for (int n = 0; n < 2; ++n) acc[m][n] = __builtin_amdgcn_mfma_f32_16x16x32_bf16(b[n], a[m], acc[m][n], 0, 0, 0);
    }
}
__device__ __forceinline__ void zero_acc(f32x4 (&acc)[4][2]) {
#pragma unroll
    for (int m = 0; m < 4; ++m)
#pragma unroll
        for (int n = 0; n < 2; ++n) acc[m][n] = (f32x4){0.f, 0.f, 0.f, 0.f};
}
__device__ __forceinline__ void stage_nat(LAS bf16_t* dst, const bf16_t* src, size_t ld, int tid) {
#pragma unroll
    for (int it = 0; it < 4; ++it) { const int idx = tid + 512 * it, row = idx >> 4, cg8 = idx & 15;
        const u32x4 v = *(const u32x4*)(src + (size_t)row * ld + cg8 * 8); *(LAS u32x4*)(dst + row * TS + cg8 * 8) = v; }
}

__device__ void phase_r1(const Params& p, LAS unsigned char* lds) {
    const int tid = threadIdx.x, wid = __builtin_amdgcn_readfirstlane(tid >> 6), lane = tid & 63, wr = wid >> 2, wc = wid & 3, fr = lane & 15, fq = lane >> 4;
    LAS bf16_t* VT = (LAS bf16_t*)lds; LAS bf16_t* KfT = VT + 128 * TS; LAS bf16_t* KbT = KfT + 128 * TS;
    const bf16_t* Kg = (const bf16_t*)(p.ws + WS_K); const bf16_t* Vg = (const bf16_t*)(p.ws + WS_V); bf16_t* KV = (bf16_t*)(p.ws + WS_KV);
    for (int unit = blockIdx.x; unit < 2048; unit += gridDim.x) {
        const int bh = unit >> 7, n = unit & 127, b = bh >> 3, h = bh & 7;
        const float lgf = log2_sigmoid(p.lg_f[h]), lgb = log2_sigmoid(p.lg_b[h]);
        const size_t rowbase = (size_t)b * SEQ + (size_t)n * 128;
        __syncthreads();
        { const int s = tid & 127, eg0 = tid >> 7;
          const float wf = exp2f((float)(128 - s) * lgf), wb = exp2f((float)(s + 1) * lgb);
#pragma unroll
          for (int it = 0; it < 4; ++it) { const int eg = eg0 + 4 * it;
              const u32x4 kw = *(const u32x4*)(Kg + (rowbase + s) * 1024 + h * 128 + eg * 8);
              const u32x4 vw = *(const u32x4*)(Vg + (rowbase + s) * 1024 + h * 128 + eg * 8);
              const unsigned kk[4] = {kw.x, kw.y, kw.z, kw.w}, vv[4] = {vw.x, vw.y, vw.z, vw.w};
#pragma unroll
              for (int j = 0; j < 4; ++j) { const float k0 = bf_lo(kk[j]), k1 = bf_hi(kk[j]); const int r0 = (eg * 8 + 2 * j) * TS + s, r1 = r0 + TS;
                  KfT[r0] = f2bf(k0 * wf); KfT[r1] = f2bf(k1 * wf); KbT[r0] = f2bf(k0 * wb); KbT[r1] = f2bf(k1 * wb);
                  VT[r0] = (bf16_t)(vv[j] & 0xffffu); VT[r1] = (bf16_t)(vv[j] >> 16); } } }
        __syncthreads();
#pragma unroll
        for (int dir = 0; dir < 2; ++dir) {
            f32x4 acc[4][2]; zero_acc(acc);
            mm128(acc, VT, dir ? KbT : KfT, wr, wc, fr, fq);
            bf16_t* dst = KV + ((size_t)((dir * 16 + bh) * 128 + n)) * 16384;
#pragma unroll
            for (int m = 0; m < 4; ++m)
#pragma unroll
                for (int nn = 0; nn < 2; ++nn) { const int e = 64 * wr + 16 * m + fr, d = 32 * wc + 16 * nn + 4 * fq;
                    u32x2 w; w.x = cvt_pk_bf16(acc[m][nn][0], acc[m][nn][1]); w.y = cvt_pk_bf16(acc[m][nn][2], acc[m][nn][3]);
                    *(u32x2*)(dst + e * 128 + d) = w; }
        }
    }
}

__device__ void phase_conv(const Params& p) {
    const int tid = threadIdx.x; const int cg4 = tid & 255, half = tid >> 8;
    const unsigned* UW = (const unsigned*)(p.ws + WS_UW); bf16_t* BR1 = (bf16_t*)(p.ws + WS_BR) + (size_t)T_TOK * 1024;
    const f32x4 k0 = *(const f32x4*)(p.conv_w + cg4 * 4), k1 = *(const f32x4*)(p.conv_w + 1024 + cg4 * 4), k2 = *(const f32x4*)(p.conv_w + 2048 + cg4 * 4);
    for (int unit = blockIdx.x; unit < 512; unit += gridDim.x) {
        const int t0 = unit * 64 + half * 32;
        u32x4 prev = (u32x4){0u, 0u, 0u, 0u}, cur, nxt;
        if ((t0 & (SEQ - 1)) != 0) prev = *(const u32x4*)(UW + (size_t)(t0 - 1) * 1024 + cg4 * 4);
        cur = *(const u32x4*)(UW + (size_t)t0 * 1024 + cg4 * 4);
        for (int i = 0; i < 32; ++i) {
            const int t = t0 + i;
            nxt = (u32x4){0u, 0u, 0u, 0u};
            if ((t & (SEQ - 1)) != SEQ - 1) nxt = *(const u32x4*)(UW + (size_t)(t + 1) * 1024 + cg4 * 4);
            const float c0 = k0[0] * bf_lo(prev.x) + k1[0] * bf_lo(cur.x) + k2[0] * bf_lo(nxt.x);
            const float c1 = k0[1] * bf_lo(prev.y) + k1[1] * bf_lo(cur.y) + k2[1] * bf_lo(nxt.y);
            const float c2 = k0[2] * bf_lo(prev.z) + k1[2] * bf_lo(cur.z) + k2[2] * bf_lo(nxt.z);
            const float c3 = k0[3] * bf_lo(prev.w) + k1[3] * bf_lo(cur.w) + k2[3] * bf_lo(nxt.w);
            u32x2 w; w.x = cvt_pk_bf16(c0 * bf_hi(cur.x), c1 * bf_hi(cur.y)); w.y = cvt_pk_bf16(c2 * bf_hi(cur.z), c3 * bf_hi(cur.w));
            *(u32x2*)(BR1 + (size_t)t * 1024 + cg4 * 4) = w;
            prev = cur; cur = nxt;
        }
    }
}

__device__ void phase_scan(const Params& p) {
    const int tid = threadIdx.x;
    const bf16_t* KV = (const bf16_t*)(p.ws + WS_KV); bf16_t* ST = (bf16_t*)(p.ws + WS_ST);
    for (int item = blockIdx.x * 512 + tid; item < 131072; item += gridDim.x * 512) {
        const int q = item & 4095, bh = (item >> 12) & 15, dir = item >> 16, h = bh & 7;
        const float lg = dir ? log2_sigmoid(p.lg_b[h]) : log2_sigmoid(p.lg_f[h]);
        const float a = exp2f(128.0f * lg);
        const size_t base = (size_t)((dir * 16 + bh) * 128) * 16384 + (size_t)q * 4;
        float s0 = 0.f, s1 = 0.f, s2 = 0.f, s3 = 0.f;
        for (int step = 0; step < 128; step += 8) {
            u32x2 kv[8];
#pragma unroll
            for (int j = 0; j < 8; ++j) { const int n = dir ? 127 - (step + j) : (step + j); kv[j] = *(const u32x2*)(KV + base + (size_t)n * 16384); }
#pragma unroll
            for (int j = 0; j < 8; ++j) { const int n = dir ? 127 - (step + j) : (step + j);
                u32x2 w; w.x = cvt_pk_bf16(s0, s1); w.y = cvt_pk_bf16(s2, s3); *(u32x2*)(ST + base + (size_t)n * 16384) = w;
                s0 = a * s0 + bf_lo(kv[j].x); s1 = a * s1 + bf_hi(kv[j].x); s2 = a * s2 + bf_lo(kv[j].y); s3 = a * s3 + bf_hi(kv[j].y); }
        }
    }
}

__device__ void phase_r3(const Params& p, LAS unsigned char* lds) {
    const int tid = threadIdx.x, wid = __builtin_amdgcn_readfirstlane(tid >> 6), lane = tid & 63, wr = wid >> 2, wc = wid & 3, fr = lane & 15, fq = lane >> 4;
    LAS bf16_t* Qs = (LAS bf16_t*)lds; LAS bf16_t* Ks = Qs + 128 * TS; LAS bf16_t* VT = Ks + 128 * TS; LAS bf16_t* Ss = VT + 128 * TS; LAS float* red = (LAS float*)(Ss + 128 * TS);
    const bf16_t* Qg = (const bf16_t*)(p.ws + WS_Q); const bf16_t* Kg = (const bf16_t*)(p.ws + WS_K); const bf16_t* Vg = (const bf16_t*)(p.ws + WS_V);
    const bf16_t* SG = (const bf16_t*)(p.ws + WS_SG); const bf16_t* ST = (const bf16_t*)(p.ws + WS_ST); bf16_t* BR0 = (bf16_t*)(p.ws + WS_BR);
    for (int unit = blockIdx.x; unit < 2048; unit += gridDim.x) {
        const int bh = unit >> 7, n = unit & 127, b = bh >> 3, h = bh & 7;
        const float lgf = log2_sigmoid(p.lg_f[h]), lgb = log2_sigmoid(p.lg_b[h]);
        const size_t rowbase = (size_t)b * SEQ + (size_t)n * 128;
        const bf16_t* Sf = ST + ((size_t)((0 * 16 + bh) * 128 + n)) * 16384; const bf16_t* Sb = ST + ((size_t)((1 * 16 + bh) * 128 + n)) * 16384;
        __syncthreads();
        stage_nat(Qs, Qg + rowbase * 1024 + h * 128, 1024, tid);
        stage_nat(Ks, Kg + rowbase * 1024 + h * 128, 1024, tid);
        stage_nat(Ss, Sf, 128, tid);
        { const int s = tid & 127, eg0 = tid >> 7;
#pragma unroll
          for (int it = 0; it < 4; ++it) { const int eg = eg0 + 4 * it;
              const u32x4 vw = *(const u32x4*)(Vg + (rowbase + s) * 1024 + h * 128 + eg * 8); const unsigned vv[4] = {vw.x, vw.y, vw.z, vw.w};
#pragma unroll
              for (int j = 0; j < 4; ++j) { const int r0 = (eg * 8 + 2 * j) * TS + s; VT[r0] = (bf16_t)(vv[j] & 0xffffu); VT[r0 + TS] = (bf16_t)(vv[j] >> 16); } } }
        __syncthreads();
        f32x4 accP[4][2], acc1[4][2], acc2[4][2];
        zero_acc(accP); mm128(accP, Qs, Ks, wr, wc, fr, fq);
#pragma unroll
        for (int m = 0; m < 4; ++m)
#pragma unroll
            for (int nn = 0; nn < 2; ++nn)
#pragma unroll
                for (int j = 0; j < 4; ++j) { const int t = 64 * wr + 16 * m + fr, s = 32 * wc + 16 * nn + 4 * fq + j; const int df = t - s;
                    accP[m][nn][j] *= (df >= 0) ? exp2f((float)df * lgf) : exp2f((float)(-df) * lgb); }
        zero_acc(acc1); mm128(acc1, Qs, Ss, wr, wc, fr, fq);
#pragma unroll
        for (int m = 0; m < 4; ++m) { const float sc = exp2f((float)(64 * wr + 16 * m + fr) * lgf);
#pragma unroll
            for (int nn = 0; nn < 2; ++nn) acc1[m][nn] *= sc; }
        __syncthreads();
#pragma unroll
        for (int m = 0; m < 4; ++m)
#pragma unroll
            for (int nn = 0; nn < 2; ++nn) { const int t = 64 * wr + 16 * m + fr, s = 32 * wc + 16 * nn + 4 * fq;
                u32x2 w; w.x = cvt_pk_bf16(accP[m][nn][0], accP[m][nn][1]); w.y = cvt_pk_bf16(accP[m][nn][2], accP[m][nn][3]);
                *(LAS u32x2*)(Ks + t * TS + s) = w; }
        stage_nat(Ss, Sb, 128, tid);
        __syncthreads();
        zero_acc(acc2); mm128(acc2, Qs, Ss, wr, wc, fr, fq);
#pragma unroll
        for (int m = 0; m < 4; ++m) { const float sc = exp2f((float)(127 - (64 * wr + 16 * m + fr)) * lgb);
#pragma unroll
            for (int nn = 0; nn < 2; ++nn) acc1[m][nn] += acc2[m][nn] * sc; }
        mm128(acc1, Ks, VT, wr, wc, fr, fq);
#pragma unroll
        for (int m = 0; m < 4; ++m) { float ss = 0.f;
#pragma unroll
            for (int nn = 0; nn < 2; ++nn) ss += (acc1[m][nn][0] * acc1[m][nn][0] + acc1[m][nn][1] * acc1[m][nn][1]) + (acc1[m][nn][2] * acc1[m][nn][2] + acc1[m][nn][3] * acc1[m][nn][3]);
            ss += __shfl_xor(ss, 16); ss += __shfl_xor(ss, 32);
            if (fq == 0) red[(64 * wr + 16 * m + fr) * 4 + wc] = ss; }
        __syncthreads();
#pragma unroll
        for (int m = 0; m < 4; ++m) { const int t = 64 * wr + 16 * m + fr; const f32x4 r4 = *(const LAS f32x4*)(red + t * 4);
            const float rstd = rsqrtf(((r4[0] + r4[1]) + (r4[2] + r4[3])) * (1.0f / 128.0f) + 1e-6f);
#pragma unroll
            for (int nn = 0; nn < 2; ++nn) { const int e0 = 32 * wc + 16 * nn + 4 * fq; const f32x4 gg = *(const f32x4*)(p.gn_gain + h * 128 + e0);
                const u32x2 sg = *(const u32x2*)(SG + (rowbase + t) * 1024 + h * 128 + e0);
                u32x2 w; w.x = cvt_pk_bf16(acc1[m][nn][0] * rstd * gg[0] * bf_lo(sg.x), acc1[m][nn][1] * rstd * gg[1] * bf_hi(sg.x));
                w.y = cvt_pk_bf16(acc1[m][nn][2] * rstd * gg[2] * bf_lo(sg.y), acc1[m][nn][3] * rstd * gg[3] * bf_hi(sg.y));
                *(u32x2*)(BR0 + (rowbase + t) * 1024 + h * 128 + e0) = w; } }
    }
}

__device__ void phase_final(const Params& p) {
    const int tid = threadIdx.x, lane = tid & 63, wv = tid >> 6; const float* SSQ = (const float*)(p.ws + WS_SSQ);
    for (int row = blockIdx.x * 8 + wv; row < T_TOK; row += gridDim.x * 8) {
        float ss = lane < 32 ? SSQ[(size_t)row * 32 + lane] : 0.f;
#pragma unroll
        for (int o = 32; o >= 1; o >>= 1) ss += __shfl_xor(ss, o);
        const float rstd = rsqrtf(ss * (1.0f / 2048.0f) + 1e-6f);
        float* yr = p.out + (size_t)row * DM;
#pragma unroll
        for (int i = 0; i < 8; ++i) { const f32x4 y = *(const f32x4*)(yr + i * 256 + lane * 4), g = *(const f32x4*)(p.final_gain + i * 256 + lane * 4);
            *(f32x4*)(yr + i * 256 + lane * 4) = y * rstd * g; }
    }
}

__device__ __forceinline__ void grid_barrier(cg::grid_group& grid) {
    asm volatile("s_waitcnt vmcnt(0) lgkmcnt(0)" ::: "memory");
    grid.sync();
    __builtin_amdgcn_fence(__ATOMIC_ACQUIRE, "agent");
    asm volatile("s_waitcnt vmcnt(0)" ::: "memory");
}

__global__ void __launch_bounds__(512, 2) fwd_megakernel(Params p) {
    extern __shared__ __attribute__((aligned(16))) unsigned char lds_raw[];
    LAS unsigned char* lds = (LAS unsigned char*)lds_raw;
    cg::grid_group grid = cg::this_grid();
    unsigned char* ws = p.ws;
    const int G = gridDim.x, c = blockIdx.x;

#ifndef PHM
#define PHM 255
#endif
    if (PHM & 1) phase_prologue(p, lds);
    grid_barrier(grid);
    if (PHM & 2) {
        pg8::Gemm g{(const bf16_t*)(ws + WS_H), (const bf16_t*)(ws + WS_WIN), T_TOK, NCOL, 2048, 0, 0};
        pg8::Order S; S.init(T_TOK, NCOL, G, c, 0);
        Epi1 E{(bf16_t*)(ws + WS_Q), (bf16_t*)(ws + WS_K), (bf16_t*)(ws + WS_V), (bf16_t*)(ws + WS_SG), (bf16_t*)(ws + WS_UW), (bf16_t*)(ws + WS_GATE), (const float*)(ws + WS_COS), (const float*)(ws + WS_SIN)};
        pg8::gemm_phase<Epi1>(lds, g, S, E);
    }
    grid_barrier(grid);
    if (PHM & 4) phase_r1(p, lds);
    if (PHM & 4) phase_conv(p);
    grid_barrier(grid);
    if (PHM & 8) phase_scan(p);
    grid_barrier(grid);
    if (PHM & 16) phase_r3(p, lds);
    grid_barrier(grid);
    if (PHM & 32) {
        pg8::Gemm g{(const bf16_t*)(ws + WS_BR), (const bf16_t*)(ws + WS_WB), T_TOK, 2048, 1024, (size_t)T_TOK * 1024 * 2, (size_t)2048 * 1024 * 2};
        pg8::Order S; S.init(T_TOK, 2048, G, c, 1);
        Epi2 E{(const bf16_t*)(ws + WS_GATE), (bf16_t*)(ws + WS_MERGED)};
        pg8::gemm_phase<Epi2>(lds, g, S, E);
    }
    grid_barrier(grid);
    if (PHM & 64) {
        pg8::Gemm g{(const bf16_t*)(ws + WS_MERGED), (const bf16_t*)(ws + WS_WO), T_TOK, 2048, 2048, 0, 0};
        pg8::Order S; S.init(T_TOK, 2048, G, c, 0);
        Epi3 E{p.x, p.out, (float*)(ws + WS_SSQ)};
        pg8::gemm_phase<Epi3>(lds, g, S, E);
    }
    grid_barrier(grid);
    if (PHM & 128) phase_final(p);
}

extern "C" void kernel_launch(void* const* d_in, const int* in_sizes, int n_in, void* d_out, int out_size, void* d_ws, size_t ws_size, hipStream_t stream) {
    static int grid_blocks = 0;
    if (!grid_blocks) {
        if (n_in != 10 || out_size != T_TOK * DM || ws_size < WS_END) { fprintf(stderr, "kernel_launch: unexpected shapes (n_in %d out %d ws %zu)\n", n_in, out_size, ws_size); grid_blocks = -1; return; }
        int dev = 0, cus = 0, per_cu = 0;
        hipGetDevice(&dev);
        hipDeviceGetAttribute(&cus, hipDeviceAttributeMultiprocessorCount, dev);
        if (hipFuncSetAttribute((const void*)fwd_megakernel, hipFuncAttributeMaxDynamicSharedMemorySize, LDS_BYTES) != hipSuccess) { fprintf(stderr, "kernel_launch: hipFuncSetAttribute failed\n"); grid_blocks = -1; return; }
        hipOccupancyMaxActiveBlocksPerMultiprocessor(&per_cu, (const void*)fwd_megakernel, 512, LDS_BYTES);
        if (per_cu < 1) { fprintf(stderr, "kernel_launch: occupancy query says %d blocks per CU\n", per_cu); per_cu = 1; }
        grid_blocks = cus * per_cu;
    }
    if (grid_blocks < 0) return;
    Params p{};
    p.x = (const float*)d_in[0]; p.norm_gain = (const float*)d_in[1]; p.w_in = (const float*)d_in[2]; p.lg_f = (const float*)d_in[3]; p.lg_b = (const float*)d_in[4];
    p.gn_gain = (const float*)d_in[5]; p.conv_w = (const float*)d_in[6]; p.w_branch = (const float*)d_in[7]; p.w_out = (const float*)d_in[8]; p.final_gain = (const float*)d_in[9];
    p.out = (float*)d_out; p.ws = (unsigned char*)d_ws;
    void* args[] = {&p};
    hipError_t e = hipLaunchCooperativeKernel((const void*)fwd_megakernel, dim3(grid_blocks), dim3(512), args, LDS_BYTES, stream);
    if (e != hipSuccess) fprintf(stderr, "cooperative launch failed: %s (grid %d)\n", hipGetErrorString(e), grid_blocks);
}
```

```cpp
#include <hip/hip_runtime.h>
#include <hip/hip_cooperative_groups.h>
#include <cstdio>
namespace cg = cooperative_groups;

#define LAS __attribute__((address_space(3)))
typedef unsigned short bf16_t;
typedef short bf16x8 __attribute__((ext_vector_type(8)));
typedef float f32x4 __attribute__((ext_vector_type(4)));
typedef unsigned u32x4 __attribute__((ext_vector_type(4)));
typedef unsigned u32x2 __attribute__((ext_vector_type(2)));

constexpr int T_TOK = 32768, DM = 2048, SEQ = 16384, NCOL = 12288;
constexpr size_t MiB = 1ull << 20;
constexpr size_t WS_H = 0, WS_KV = 0, WS_WIN = 128 * MiB, WS_WB = 176 * MiB, WS_WO = 184 * MiB, WS_COS = 192 * MiB, WS_SIN = 196 * MiB,
                 WS_Q = 200 * MiB, WS_K = 264 * MiB, WS_MERGED = 200 * MiB, WS_V = 328 * MiB, WS_SG = 392 * MiB, WS_UW = 456 * MiB, WS_ST = 456 * MiB,
                 WS_GATE = 584 * MiB, WS_BR = 840 * MiB, WS_SSQ = 968 * MiB, WS_END = 972 * MiB;
constexpr int LDS_BYTES = 147456;
constexpr int TS = 136;

struct Params {
    const float* x; const float* norm_gain; const float* w_in; const float* lg_f; const float* lg_b; const float* gn_gain;
    const float* conv_w; const float* w_branch; const float* w_out; const float* final_gain; float* out; unsigned char* ws;
};

typedef __bf16 bf16x2_t __attribute__((ext_vector_type(2)));
typedef float f32x2_t __attribute__((ext_vector_type(2)));
__device__ __forceinline__ unsigned cvt_pk_bf16(float lo, float hi) { f32x2_t v = {lo, hi}; bf16x2_t b = __builtin_convertvector(v, bf16x2_t); return __builtin_bit_cast(unsigned, b); }
__device__ __forceinline__ bf16_t f2bf(float f) { unsigned u = __float_as_uint(f); u += 0x7FFFu + ((u >> 16) & 1u); return (bf16_t)(u >> 16); }
__device__ __forceinline__ float bf_lo(unsigned w) { return __uint_as_float(w << 16); }
__device__ __forceinline__ float bf_hi(unsigned w) { return __uint_as_float(w & 0xffff0000u); }
__device__ __forceinline__ float sigmoidf_(float x) { return __builtin_amdgcn_rcpf(1.0f + __expf(-x)); }
__device__ __forceinline__ float log2_sigmoid(float x) { return -log1pf(expf(-x)) * 1.4426950408889634f; }

namespace pg8 {
constexpr int BM = 256, BK = 64, HALF = 128, HTB = HALF * BK * 2, STAGE_BYTES = 8 * HTB, NXCD = 8, WGM = 8;
__host__ __device__ __forceinline__ int lds_byte(int r, int c) { const int st = (r >> 4) * 2 + (c >> 5), rr = r & 15, cc = c & 31, ob = rr * 64 + cc * 2; return st * 1024 + (ob ^ (((ob >> 9) & 1) << 5)); }
__host__ __device__ __forceinline__ void stage_rc(int b, int& R, int& C) { const int st = b / 1024, sb = b % 1024, swz = sb ^ (((sb >> 9) & 1) << 5); R = (st >> 1) * 16 + swz / 64; C = (st & 1) * 32 + (swz % 64) / 2; }
__host__ __device__ __forceinline__ int perm32(int rho) { const int n = rho >> 4, i = rho & 15; return 8 * (i >> 2) + 4 * n + (i & 3); }

struct Unit { int pm, pn, z; };
struct Gemm { const bf16_t* A; const bf16_t* Bt; int M, N, K; size_t zA, zB; };

struct Order {
    int nM, nN, nwg, G, c, zsh;
    __device__ void init(int M, int N, int G_, int c_, int zsh_) { nM = M / BM; nN = N / BM; nwg = nM * nN; G = G_; c = c_; zsh = zsh_; }
    __device__ bool next(int i, Unit& u) const {
        const int ti = i >> zsh; u.z = i & ((1 << zsh) - 1);
        const long L = (long)ti * G + c; if (L >= nwg) return false;
        int wgid = (int)L; { const int q = nwg / NXCD, r = nwg % NXCD, xcd = wgid % NXCD, off = wgid / NXCD; wgid = (xcd < r ? xcd * (q + 1) : r * (q + 1) + (xcd - r) * q) + off; }
        const int nig = WGM * nN, gid = wgid / nig, fm = gid * WGM, gsz = (nM - fm) < WGM ? (nM - fm) : WGM;
        u.pm = fm + ((wgid % nig) % gsz); u.pn = (wgid % nig) / gsz; return true;
    }
};

template <class Epi>
__device__ __forceinline__ void gemm_phase(LAS unsigned char* lds, const Gemm g, const Order& S, const Epi& E) {
    const int tid = threadIdx.x, wid = __builtin_amdgcn_readfirstlane(tid >> 6), lane = tid & 63, wr = wid >> 2, wc = wid & 3, fr = lane & 15, fq = lane >> 4;
    const int K = g.K, nt = K / BK;
    unsigned voffA[2], voffB[2];
#pragma unroll
    for (int i = 0; i < 2; ++i) { int R, C; stage_rc(tid * 16 + i * 8192, R, C); const int Rb = Epi::PERM ? ((R & ~31) + perm32(R & 31)) : R;
        voffA[i] = (unsigned)(R * K + C) * 2u; voffB[i] = (unsigned)(Rb * K + C) * 2u; }
    const size_t kstep = (size_t)(BK * 2);
    const size_t hstep = (size_t)HALF * K * 2;
    const size_t tstep = 2 * hstep;
    const unsigned ldsw = (unsigned)wid * 1024u;
    const int aoff = lds_byte(wr * 64 + fr, fq * 8), boff = lds_byte(wc * 32 + fr, fq * 8);
#define PG8_SA(b, h) (((b) * 2 + (h)) * HTB)
#define PG8_SB(b, h) ((4 + (b) * 2 + (h)) * HTB)
#define PG8_STAGE(bufoff, gbase, voff) do { _Pragma("unroll") for (int _i = 0; _i < 2; ++_i) \
        __builtin_amdgcn_global_load_lds((const unsigned*)((const char*)(gbase) + (voff)[_i]), (LAS unsigned*)(lds + (bufoff) + ldsw + _i * 8192), 16, 0, 0); } while (0)
#define PG8_LDA(dst, b, h) do { _Pragma("unroll") for (int m = 0; m < 4; ++m) _Pragma("unroll") for (int k = 0; k < 2; ++k) dst[m][k] = *(const LAS bf16x8*)(lds + PG8_SA(b, h) + aoff + m * 2048 + k * 1024); } while (0)
#define PG8_LDB(dst, b, h) do { _Pragma("unroll") for (int n = 0; n < 2; ++n) _Pragma("unroll") for (int k = 0; k < 2; ++k) dst[n][k] = *(const LAS bf16x8*)(lds + PG8_SB(b, h) + boff + n * 2048 + k * 1024); } while (0)
#define PG8_MMA(ai, bj, At, Bt) do { __builtin_amdgcn_s_setprio(1); _Pragma("unroll") for (int m = 0; m < 4; ++m) _Pragma("unroll") for (int n = 0; n < 2; ++n) _Pragma("unroll") for (int k = 0; k < 2; ++k) \
        acc[ai][bj][m][n] = __builtin_amdgcn_mfma_f32_16x16x32_bf16(Bt[n][k], At[m][k], acc[ai][bj][m][n], 0, 0, 0); __builtin_amdgcn_s_setprio(0); } while (0)
#define PG8_WAIT_V(n) asm volatile("s_waitcnt vmcnt(" #n ")" ::: "memory")
#define PG8_WAIT_L(n) asm volatile("s_waitcnt lgkmcnt(" #n ")" ::: "memory")
#define PG8_BAR __builtin_amdgcn_s_barrier()
#define PG8_SCHED __builtin_amdgcn_sched_barrier(0)
    Unit cur, nxt; int ui = 0;
    if (!S.next(0, cur)) return;
    f32x4 acc[2][2][4][2];
#pragma unroll
    for (int a = 0; a < 2; ++a)
#pragma unroll
        for (int b = 0; b < 2; ++b)
#pragma unroll
            for (int m = 0; m < 4; ++m)
#pragma unroll
                for (int n = 0; n < 2; ++n) acc[a][b][m][n] = (f32x4){0.f, 0.f, 0.f, 0.f};
    bf16x8 At[4][2], B0[2][2], B1[2][2];
    const char* cA = (const char*)g.A + (size_t)cur.pm * tstep + (size_t)cur.z * g.zA; const char* cB = (const char*)g.Bt + (size_t)cur.pn * tstep + (size_t)cur.z * g.zB;
    PG8_STAGE(PG8_SB(0, 0), cB, voffB); PG8_STAGE(PG8_SA(0, 0), cA, voffA); PG8_STAGE(PG8_SB(0, 1), cB + hstep, voffB); PG8_STAGE(PG8_SA(0, 1), cA + hstep, voffA);
    if (wr == 1) PG8_BAR;
    PG8_WAIT_V(4); PG8_BAR;
    PG8_STAGE(PG8_SB(1, 0), cB + kstep, voffB); PG8_STAGE(PG8_SA(1, 0), cA + kstep, voffA); PG8_STAGE(PG8_SB(1, 1), cB + hstep + kstep, voffB);
    PG8_WAIT_V(6); PG8_BAR;
    for (;;) {
        const bool has_next = S.next(ui + 1, nxt);
        const char* nA = has_next ? (const char*)g.A + (size_t)nxt.pm * tstep + (size_t)nxt.z * g.zA : cA;
        const char* nB = has_next ? (const char*)g.Bt + (size_t)nxt.pn * tstep + (size_t)nxt.z * g.zB : cB;
        for (int t = 0; t < nt; t += 2) {
            const bool last = (t == nt - 2);
            const char* a1 = cA + (size_t)(t + 1) * kstep;
            const char* a2 = last ? nA : cA + (size_t)(t + 2) * kstep; const char* b2 = last ? nB : cB + (size_t)(t + 2) * kstep;
            const char* a3 = a2 + kstep; const char* b3 = b2 + kstep;
            PG8_LDB(B0, 0, 0); PG8_SCHED; PG8_LDA(At, 0, 0); PG8_STAGE(PG8_SA(1, 1), a1 + hstep, voffA);
            PG8_WAIT_L(8); PG8_BAR; PG8_WAIT_L(0); PG8_MMA(0, 0, At, B0); PG8_BAR; PG8_SCHED;
            PG8_LDB(B1, 0, 1); PG8_STAGE(PG8_SB(0, 0), b2, voffB);
            PG8_BAR; PG8_WAIT_L(0); PG8_MMA(0, 1, At, B1); PG8_BAR;
            PG8_LDA(At, 0, 1); PG8_STAGE(PG8_SA(0, 0), a2, voffA);
            PG8_BAR; PG8_WAIT_L(0); PG8_MMA(1, 0, At, B0); PG8_BAR; PG8_SCHED;
            PG8_STAGE(PG8_SB(0, 1), b2 + hstep, voffB);
            PG8_WAIT_V(6); PG8_BAR; PG8_MMA(1, 1, At, B1); PG8_BAR;
            PG8_LDB(B0, 1, 0); PG8_SCHED; PG8_LDA(At, 1, 0); PG8_STAGE(PG8_SA(0, 1), a2 + hstep, voffA);
            PG8_WAIT_L(8); PG8_BAR; PG8_WAIT_L(0); PG8_MMA(0, 0, At, B0); PG8_BAR; PG8_SCHED;
            PG8_LDB(B1, 1, 1); PG8_STAGE(PG8_SB(1, 0), b3, voffB);
            PG8_BAR; PG8_WAIT_L(0); PG8_MMA(0, 1, At, B1); PG8_BAR;
            PG8_LDA(At, 1, 1); PG8_STAGE(PG8_SA(1, 0), a3, voffA);
            PG8_BAR; PG8_WAIT_L(0); PG8_MMA(1, 0, At, B0); PG8_BAR; PG8_SCHED;
            PG8_STAGE(PG8_SB(1, 1), b3 + hstep, voffB);
            PG8_WAIT_V(6); PG8_BAR; PG8_MMA(1, 1, At, B1); PG8_BAR;
        }
        E(acc, cur, wr, wc, fr, fq);
        if (!has_next) break;
#pragma unroll
        for (int a = 0; a < 2; ++a)
#pragma unroll
            for (int b = 0; b < 2; ++b)
#pragma unroll
                for (int m = 0; m < 4; ++m)
#pragma unroll
                    for (int n = 0; n < 2; ++n) acc[a][b][m][n] = (f32x4){0.f, 0.f, 0.f, 0.f};
        cur = nxt; cA = nA; cB = nB; ++ui;
    }
    PG8_WAIT_V(0);
    if (wr == 0) PG8_BAR;
    PG8_BAR;
#undef PG8_SA
#undef PG8_SB
#undef PG8_STAGE
#undef PG8_LDA
#undef PG8_LDB
#undef PG8_MMA
#undef PG8_WAIT_V
#undef PG8_WAIT_L
#undef PG8_BAR
#undef PG8_SCHED
}
}

struct Epi1 {
    static constexpr bool PERM = true;
    bf16_t *Q, *K, *V, *SG, *UW, *GATE; const float *COS, *SIN;
    __device__ __forceinline__ void operator()(const f32x4 (&acc)[2][2][4][2], const pg8::Unit& u, int wr, int wc, int fr, int fq) const {
        const int row0 = u.pm * 256 + wr * 64 + fr, lc = wc * 32 + 8 * fq, pn = u.pn;
        if (pn < 8) {
            bf16_t* base = (pn < 4 ? Q : K) + (pn & 3) * 256 + lc;
            const int i0 = lc >> 1;
#pragma unroll
            for (int ai = 0; ai < 2; ++ai) {
                f32x4 cs[4], sn[4];
#pragma unroll
                for (int m = 0; m < 4; ++m) { const int pos = (row0 + ai * 128 + m * 16) & (SEQ - 1);
                    cs[m] = *(const f32x4*)(COS + pos * 64 + i0); sn[m] = *(const f32x4*)(SIN + pos * 64 + i0); }
#pragma unroll
                for (int m = 0; m < 4; ++m) {
                    const int row = row0 + ai * 128 + m * 16;
#pragma unroll
                    for (int bj = 0; bj < 2; ++bj) {
                        const f32x4 v0 = acc[ai][bj][m][0], v1 = acc[ai][bj][m][1]; u32x4 w;
                        w.x = cvt_pk_bf16(v0[0] * cs[m][0] - v0[1] * sn[m][0], v0[1] * cs[m][0] + v0[0] * sn[m][0]);
                        w.y = cvt_pk_bf16(v0[2] * cs[m][1] - v0[3] * sn[m][1], v0[3] * cs[m][1] + v0[2] * sn[m][1]);
                        w.z = cvt_pk_bf16(v1[0] * cs[m][2] - v1[1] * sn[m][2], v1[1] * cs[m][2] + v1[0] * sn[m][2]);
                        w.w = cvt_pk_bf16(v1[2] * cs[m][3] - v1[3] * sn[m][3], v1[3] * cs[m][3] + v1[2] * sn[m][3]);
                        *(u32x4*)(base + (size_t)row * 1024 + bj * 128) = w; }
                }
            }
        } else if (pn < 16) {
            const bool act = pn >= 12;
            bf16_t* base = (act ? SG : V) + (pn & 3) * 256 + lc;
#pragma unroll
            for (int ai = 0; ai < 2; ++ai)
#pragma unroll
                for (int m = 0; m < 4; ++m) {
                    const int row = row0 + ai * 128 + m * 16;
#pragma unroll
                    for (int bj = 0; bj < 2; ++bj) {
                        f32x4 v0 = acc[ai][bj][m][0], v1 = acc[ai][bj][m][1];
                        if (act) {
#pragma unroll
                            for (int j = 0; j < 4; ++j) { v0[j] = v0[j] * sigmoidf_(v0[j]); v1[j] = v1[j] * sigmoidf_(v1[j]); } }
                        u32x4 w; w.x = cvt_pk_bf16(v0[0], v0[1]); w.y = cvt_pk_bf16(v0[2], v0[3]); w.z = cvt_pk_bf16(v1[0], v1[1]); w.w = cvt_pk_bf16(v1[2], v1[3]);
                        *(u32x4*)(base + (size_t)row * 1024 + bj * 128) = w; }
                }
        } else if (pn < 32) {
            const int ch0 = 64 * (pn - 16) + 16 * wc + 4 * fq;
#pragma unroll
            for (int ai = 0; ai < 2; ++ai)
#pragma unroll
                for (int m = 0; m < 4; ++m) {
                    const int row = row0 + ai * 128 + m * 16;
                    const f32x4 cc = acc[ai][0][m][0], cx = acc[ai][0][m][1], cb = acc[ai][1][m][0], g = acc[ai][1][m][1];
                    u32x4 w;
                    w.x = cvt_pk_bf16(cc[0] * cx[0], cb[0] * g[0] * sigmoidf_(g[0]));
                    w.y = cvt_pk_bf16(cc[1] * cx[1], cb[1] * g[1] * sigmoidf_(g[1]));
                    w.z = cvt_pk_bf16(cc[2] * cx[2], cb[2] * g[2] * sigmoidf_(g[2]));
                    w.w = cvt_pk_bf16(cc[3] * cx[3], cb[3] * g[3] * sigmoidf_(g[3]));
                    *(u32x4*)(UW + ((size_t)row * 1024 + ch0) * 2) = w;
                }
        } else {
            bf16_t* base = GATE + (pn - 32) * 256 + lc;
#pragma unroll
            for (int ai = 0; ai < 2; ++ai)
#pragma unroll
                for (int m = 0; m < 4; ++m) {
                    const int row = row0 + ai * 128 + m * 16;
#pragma unroll
                    for (int bj = 0; bj < 2; ++bj) {
                        const f32x4 v0 = acc[ai][bj][m][0], v1 = acc[ai][bj][m][1];
                        u32x4 w; w.x = cvt_pk_bf16(sigmoidf_(v0[0]), sigmoidf_(v0[1])); w.y = cvt_pk_bf16(sigmoidf_(v0[2]), sigmoidf_(v0[3]));
                        w.z = cvt_pk_bf16(sigmoidf_(v1[0]), sigmoidf_(v1[1])); w.w = cvt_pk_bf16(sigmoidf_(v1[2]), sigmoidf_(v1[3]));
                        *(u32x4*)(base + (size_t)row * 4096 + bj * 128) = w; }
                }
        }
    }
};

struct Epi2 {
    static constexpr bool PERM = true;
    const bf16_t* GATE; bf16_t* MERGED;
    __device__ __forceinline__ void operator()(const f32x4 (&acc)[2][2][4][2], const pg8::Unit& u, int wr, int wc, int fr, int fq) const {
        const int row0 = u.pm * 256 + wr * 64 + fr, col = u.pn * 256 + wc * 32 + 8 * fq;
#pragma unroll
        for (int ai = 0; ai < 2; ++ai) {
            u32x4 gw[4][2], pw[4][2];
#pragma unroll
            for (int m = 0; m < 4; ++m)
#pragma unroll
                for (int bj = 0; bj < 2; ++bj) { const int row = row0 + ai * 128 + m * 16;
                    gw[m][bj] = *(const u32x4*)(GATE + (size_t)row * 4096 + u.z * 2048 + col + bj * 128);
                    pw[m][bj] = u.z ? *(const u32x4*)(MERGED + (size_t)row * 2048 + col + bj * 128) : (u32x4){0u, 0u, 0u, 0u}; }
#pragma unroll
            for (int m = 0; m < 4; ++m)
#pragma unroll
                for (int bj = 0; bj < 2; ++bj) { const int row = row0 + ai * 128 + m * 16;
                    const u32x4 g = gw[m][bj], pv = pw[m][bj]; const f32x4 v0 = acc[ai][bj][m][0], v1 = acc[ai][bj][m][1];
                    u32x4 w;
                    w.x = cvt_pk_bf16(bf_lo(g.x) * v0[0] + bf_lo(pv.x), bf_hi(g.x) * v0[1] + bf_hi(pv.x));
                    w.y = cvt_pk_bf16(bf_lo(g.y) * v0[2] + bf_lo(pv.y), bf_hi(g.y) * v0[3] + bf_hi(pv.y));
                    w.z = cvt_pk_bf16(bf_lo(g.z) * v1[0] + bf_lo(pv.z), bf_hi(g.z) * v1[1] + bf_hi(pv.z));
                    w.w = cvt_pk_bf16(bf_lo(g.w) * v1[2] + bf_lo(pv.w), bf_hi(g.w) * v1[3] + bf_hi(pv.w));
                    *(u32x4*)(MERGED + (size_t)row * 2048 + col + bj * 128) = w; }
        }
    }
};

struct Epi3 {
    static constexpr bool PERM = false;
    const float* X; float* OUT; float* SSQ;
    __device__ __forceinline__ void operator()(const f32x4 (&acc)[2][2][4][2], const pg8::Unit& u, int wr, int wc, int fr, int fq) const {
        const int row0 = u.pm * 256 + wr * 64 + fr, col0 = u.pn * 256 + wc * 32 + 4 * fq;
#pragma unroll
        for (int ai = 0; ai < 2; ++ai) {
            f32x4 xv[4][2][2];
#pragma unroll
            for (int m = 0; m < 4; ++m)
#pragma unroll
                for (int bj = 0; bj < 2; ++bj)
#pragma unroll
                    for (int n = 0; n < 2; ++n) xv[m][bj][n] = *(const f32x4*)(X + (size_t)(row0 + ai * 128 + m * 16) * 2048 + col0 + bj * 128 + n * 16);
#pragma unroll
            for (int m = 0; m < 4; ++m) {
                const int row = row0 + ai * 128 + m * 16; const size_t off = (size_t)row * 2048 + col0; float ss = 0.f;
#pragma unroll
                for (int bj = 0; bj < 2; ++bj)
#pragma unroll
                    for (int n = 0; n < 2; ++n) { const f32x4 y = xv[m][bj][n] + acc[ai][bj][m][n];
                        *(f32x4*)(OUT + off + bj * 128 + n * 16) = y; ss += (y[0] * y[0] + y[1] * y[1]) + (y[2] * y[2] + y[3] * y[3]); }
                ss += __shfl_xor(ss, 16); ss += __shfl_xor(ss, 32);
                if (fq == 0) SSQ[(size_t)row * 32 + u.pn * 4 + wc] = ss;
            }
        }
    }
};

__device__ __forceinline__ int win_src_col(int c, float& scale) {
    scale = 1.0f;
    if (c < 2048) { const int p = c & 127; if (c >= 1024) scale = 0.08838834764831845f; return (c & ~127) + (p >> 1) + 64 * (p & 1); }
    if (c < 4096 || c >= 8192) return c;
    const int l = (c - 4096) & 255, ct = (c - 4096) >> 8, bj = l >> 7, rem = l & 127, wc = rem >> 5, fq = (rem & 31) >> 3, j8 = rem & 7;
    const int ch = 64 * ct + 16 * wc + 4 * fq + (j8 & 3);
    const int qty = bj == 0 ? (j8 < 4 ? 1 : 2) : (j8 < 4 ? 0 : 3);
    return 4096 + qty * 1024 + ch;
}

__device__ void phase_prologue(const Params& p, LAS unsigned char* lds) {
    const int tid = threadIdx.x, G = gridDim.x;
    unsigned char* ws = p.ws;
    LAS float* tile = (LAS float*)lds;
    for (int tix = blockIdx.x; tix < 8192; tix += G) {
        const float* src; bf16_t* dst; int ld, Kd, n0, k0; bool isin = false;
        if (tix < 6144) { src = p.w_in; dst = (bf16_t*)(ws + WS_WIN); ld = NCOL; Kd = 2048; n0 = (tix >> 5) * 64; k0 = (tix & 31) * 64; isin = true; }
        else if (tix < 7168) { const int t = tix - 6144, z = t >> 9, tt = t & 511; src = p.w_branch + (size_t)z * 1024 * 2048; dst = (bf16_t*)(ws + WS_WB) + (size_t)z * 2048 * 1024; ld = 2048; Kd = 1024; n0 = (tt >> 4) * 64; k0 = (tt & 15) * 64; }
        else { const int t = tix - 7168; src = p.w_out; dst = (bf16_t*)(ws + WS_WO); ld = 2048; Kd = 2048; n0 = (t >> 5) * 64; k0 = (t & 31) * 64; }
        __syncthreads();
        { const int nn = tid & 63, kk0 = tid >> 6; float sc = 1.0f; const int scol = isin ? win_src_col(n0 + nn, sc) : (n0 + nn);
#pragma unroll
          for (int it = 0; it < 8; ++it) { const int kk = kk0 + 8 * it; tile[kk * 65 + nn] = src[(size_t)(k0 + kk) * ld + scol] * sc; } }
        __syncthreads();
        { const int nn = tid >> 3, kq = tid & 7; float v[8];
#pragma unroll
          for (int j = 0; j < 8; ++j) v[j] = tile[(kq * 8 + j) * 65 + nn];
          u32x4 w; w.x = cvt_pk_bf16(v[0], v[1]); w.y = cvt_pk_bf16(v[2], v[3]); w.z = cvt_pk_bf16(v[4], v[5]); w.w = cvt_pk_bf16(v[6], v[7]);
          *(u32x4*)(dst + (size_t)(n0 + nn) * Kd + k0 + kq * 8) = w; }
    }
    {
        float* COS = (float*)(ws + WS_COS); float* SIN = (float*)(ws + WS_SIN);
        for (int idx = blockIdx.x * 512 + tid; idx < SEQ * 64; idx += G * 512) {
            const int pos = idx >> 6, i = idx & 63;
            const float invf = (float)exp2(-(double)i * (13.287712379549449 / 64.0));
            const float angf = (float)pos * invf;
            const double a = (double)angf;
            const double n = rint(a * 0.15915494309189535);
            double r = fma(-n, 6.283185307179586, a); r = fma(-n, 2.4492935982947064e-16, r);
            const double qd = rint(r * 0.6366197723675814); const int q = (int)qd;
            double y = fma(-qd, 1.5707963267948966, r); y = fma(-qd, 6.123233995736766e-17, y);
            const double y2 = y * y;
            double sp = -2.5052108385441720e-08; sp = fma(sp, y2, 2.7557319223985893e-06); sp = fma(sp, y2, -1.9841269841269841e-04); sp = fma(sp, y2, 8.3333333333333332e-03); sp = fma(sp, y2, -1.6666666666666666e-01);
            const double sy = fma(y * y2, sp, y);
            double cp = 2.0876756987868099e-09; cp = fma(cp, y2, -2.7557319223985888e-07); cp = fma(cp, y2, 2.4801587301587302e-05); cp = fma(cp, y2, -1.3888888888888889e-03); cp = fma(cp, y2, 4.1666666666666664e-02); cp = fma(cp, y2, -0.5);
            const double cy = fma(y2, cp, 1.0);
            double s, c;
            switch (q & 3) { case 0: s = sy; c = cy; break; case 1: s = cy; c = -sy; break; case 2: s = -sy; c = -cy; break; default: s = -cy; c = sy; break; }
            COS[idx] = (float)c; SIN[idx] = (float)s;
        }
    }
    {
        bf16_t* H = (bf16_t*)(ws + WS_H); const int lane = tid & 63, wv = tid >> 6;
        f32x4 gn[8];
#pragma unroll
        for (int i = 0; i < 8; ++i) gn[i] = *(const f32x4*)(p.norm_gain + i * 256 + lane * 4);
        for (int row = (blockIdx.x * 8 + wv) * 2; row < T_TOK; row += G * 16) {
            f32x4 v[2][8]; float ss[2] = {0.f, 0.f};
#pragma unroll
            for (int r = 0; r < 2; ++r)
#pragma unroll
                for (int i = 0; i < 8; ++i) v[r][i] = *(const f32x4*)(p.x + (size_t)(row + r) * DM + i * 256 + lane * 4);
#pragma unroll
            for (int r = 0; r < 2; ++r) {
#pragma unroll
                for (int i = 0; i < 8; ++i) ss[r] += (v[r][i][0] * v[r][i][0] + v[r][i][1] * v[r][i][1]) + (v[r][i][2] * v[r][i][2] + v[r][i][3] * v[r][i][3]);
#pragma unroll
                for (int o = 32; o >= 1; o >>= 1) ss[r] += __shfl_xor(ss[r], o);
                const float rstd = rsqrtf(ss[r] * (1.0f / 2048.0f) + 1e-6f);
#pragma unroll
                for (int i = 0; i < 8; ++i) {
                    u32x2 w; w.x = cvt_pk_bf16(v[r][i][0] * rstd * gn[i][0], v[r][i][1] * rstd * gn[i][1]); w.y = cvt_pk_bf16(v[r][i][2] * rstd * gn[i][2], v[r][i][3] * rstd * gn[i][3]);
                    *(u32x2*)(H + (size_t)(row + r) * DM + i * 256 + lane * 4) = w; }
            }
        }
    }
}

__device__ __forceinline__ void mm128(f32x4 (&acc)[4][2], const LAS bf16_t* At, const LAS bf16_t* Bt, int wr, int wc, int fr, int fq) {
    __builtin_amdgcn_sched_barrier(0);
#pragma unroll 1
    for (int kb = 0; kb < 4; ++kb) {
        bf16x8 a[4], b[2];
#pragma unroll
        for (int m = 0; m < 4; ++m) a[m] = *(const LAS bf16x8*)(At + (64 * wr + 16 * m + fr) * TS + kb * 32 + fq * 8);
#pragma unroll
        for (int n = 0; n < 2; ++n) b[n] = *(const LAS bf16x8*)(Bt + (32 * wc + 16 * n + fr) * TS + kb * 32 + fq * 8);
#pragma unroll
        for (int m = 0; m < 4; ++m)
#pragma unroll
            for (int n = 0; n < 2; ++n) acc[m][n] = __builtin_amdgcn_mfma_f32_16x16x32_bf16(b[n], a[m], acc[m][n], 0, 0, 0);
    }
}
__device__ __forceinline__ void zero_acc(f32x4 (&acc)[4][2]) {
#pragma unroll
    for (int m = 0; m < 4; ++m)
#pragma unroll
        for (int n = 0; n < 2; ++n) acc[m][n] = (f32x4){0.f, 0.f, 0.f, 0.f};
}
__device__ __forceinline__ void stage_nat(LAS bf16_t* dst, const bf16_t* src, size_t ld, int tid) {
#pragma unroll
    for (int it = 0; it < 4; ++it) { const int idx = tid + 512 * it, row = idx >> 4, cg8 = idx & 15;
        const u32x4 v = *(const u32x4*)(src + (size_t)row * ld + cg8 * 8); *(LAS u32x4*)(dst + row * TS + cg8 * 8) = v; }
}

__device__ void phase_r1(const Params& p, LAS unsigned char* lds) {
    const int tid = threadIdx.x, wid = __builtin_amdgcn_readfirstlane(tid >> 6), lane = tid & 63, wr = wid >> 2, wc = wid & 3, fr = lane & 15, fq = lane >> 4;
    LAS bf16_t* VT = (LAS bf16_t*)lds; LAS bf16_t* KfT = VT + 128 * TS; LAS bf16_t* KbT = KfT + 128 * TS;
    const bf16_t* Kg = (const bf16_t*)(p.ws + WS_K); const bf16_t* Vg = (const bf16_t*)(p.ws + WS_V); bf16_t* KV = (bf16_t*)(p.ws + WS_KV);
    for (int unit = blockIdx.x; unit < 2048; unit += gridDim.x) {
        const int bh = unit >> 7, n = unit & 127, b = bh >> 3, h = bh & 7;
        const float lgf = log2_sigmoid(p.lg_f[h]), lgb = log2_sigmoid(p.lg_b[h]);
        const size_t rowbase = (size_t)b * SEQ + (size_t)n * 128;
        __syncthreads();
        { const int s = tid & 127, eg0 = tid >> 7;
          const float wf = exp2f((float)(128 - s) * lgf), wb = exp2f((float)(s + 1) * lgb);
#pragma unroll
          for (int it = 0; it < 4; ++it) { const int eg = eg0 + 4 * it;
              const u32x4 kw = *(const u32x4*)(Kg + (rowbase + s) * 1024 + h * 128 + eg * 8);
              const u32x4 vw = *(const u32x4*)(Vg + (rowbase + s) * 1024 + h * 128 + eg * 8);
              const unsigned kk[4] = {kw.x, kw.y, kw.z, kw.w}, vv[4] = {vw.x, vw.y, vw.z, vw.w};
#pragma unroll
              for (int j = 0; j < 4; ++j) { const float k0 = bf_lo(kk[j]), k1 = bf_hi(kk[j]); const int r0 = (eg * 8 + 2 * j) * TS + s, r1 = r0 + TS;
                  KfT[r0] = f2bf(k0 * wf); KfT[r1] = f2bf(k1 * wf); KbT[r0] = f2bf(k0 * wb); KbT[r1] = f2bf(k1 * wb);
                  VT[r0] = (bf16_t)(vv[j] & 0xffffu); VT[r1] = (bf16_t)(vv[j] >> 16); } } }
        __syncthreads();
#pragma unroll
        for (int dir = 0; dir < 2; ++dir) {
            f32x4 acc[4][2]; zero_acc(acc);
            mm128(acc, VT, dir ? KbT : KfT, wr, wc, fr, fq);
            bf16_t* dst = KV + ((size_t)((dir * 16 + bh) * 128 + n)) * 16384;
#pragma unroll
            for (int m = 0; m < 4; ++m)
#pragma unroll
                for (int nn = 0; nn < 2; ++nn) { const int e = 64 * wr + 16 * m + fr, d = 32 * wc + 16 * nn + 4 * fq;
                    u32x2 w; w.x = cvt_pk_bf16(acc[m][nn][0], acc[m][nn][1]); w.y = cvt_pk_bf16(acc[m][nn][2], acc[m][nn][3]);
                    *(u32x2*)(dst + e * 128 + d) = w; }
        }
    }
}

__device__ void phase_conv(const Params& p) {
    const int tid = threadIdx.x; const int cg4 = tid & 255, half = tid >> 8;
    const unsigned* UW = (const unsigned*)(p.ws + WS_UW); bf16_t* BR1 = (bf16_t*)(p.ws + WS_BR) + (size_t)T_TOK * 1024;
    const f32x4 k0 = *(const f32x4*)(p.conv_w + cg4 * 4), k1 = *(const f32x4*)(p.conv_w + 1024 + cg4 * 4), k2 = *(const f32x4*)(p.conv_w + 2048 + cg4 * 4);
    for (int unit = blockIdx.x; unit < 512; unit += gridDim.x) {
        const int tb = unit * 64 + half * 32;
        for (int bt = 0; bt < 4; ++bt) {
            const int t0 = tb + bt * 8;
            u32x4 r[10];
#pragma unroll
            for (int j = 0; j < 10; ++j) {
                const bool valid = !((j == 0 && (t0 & (SEQ - 1)) == 0) || (j == 9 && ((t0 + 8) & (SEQ - 1)) == 0));
                r[j] = valid ? *(const u32x4*)(UW + (size_t)(t0 - 1 + j) * 1024 + cg4 * 4) : (u32x4){0u, 0u, 0u, 0u}; }
#pragma unroll
            for (int i = 0; i < 8; ++i) {
                const u32x4 prev = r[i], cur = r[i + 1], nxt = r[i + 2];
                const float c0 = k0[0] * bf_lo(prev.x) + k1[0] * bf_lo(cur.x) + k2[0] * bf_lo(nxt.x);
                const float c1 = k0[1] * bf_lo(prev.y) + k1[1] * bf_lo(cur.y) + k2[1] * bf_lo(nxt.y);
                const float c2 = k0[2] * bf_lo(prev.z) + k1[2] * bf_lo(cur.z) + k2[2] * bf_lo(nxt.z);
                const float c3 = k0[3] * bf_lo(prev.w) + k1[3] * bf_lo(cur.w) + k2[3] * bf_lo(nxt.w);
                u32x2 w; w.x = cvt_pk_bf16(c0 * bf_hi(cur.x), c1 * bf_hi(cur.y)); w.y = cvt_pk_bf16(c2 * bf_hi(cur.z), c3 * bf_hi(cur.w));
                *(u32x2*)(BR1 + (size_t)(t0 + i) * 1024 + cg4 * 4) = w;
            }
        }
    }
}

__device__ void phase_scan(const Params& p) {
    const int tid = threadIdx.x;
    const bf16_t* KV = (const bf16_t*)(p.ws + WS_KV); bf16_t* ST = (bf16_t*)(p.ws + WS_ST);
    for (int item = blockIdx.x * 512 + tid; item < 131072; item += gridDim.x * 512) {
        const int q = item & 4095, bh = (item >> 12) & 15, dir = item >> 16, h = bh & 7;
        const float lg = dir ? log2_sigmoid(p.lg_b[h]) : log2_sigmoid(p.lg_f[h]);
        const float a = exp2f(128.0f * lg);
        const size_t base = (size_t)((dir * 16 + bh) * 128) * 16384 + (size_t)q * 4;
        float s0 = 0.f, s1 = 0.f, s2 = 0.f, s3 = 0.f;
        for (int step = 0; step < 128; step += 8) {
            u32x2 kv[8];
#pragma unroll
            for (int j = 0; j < 8; ++j) { const int n = dir ? 127 - (step + j) : (step + j); kv[j] = *(const u32x2*)(KV + base + (size_t)n * 16384); }
#pragma unroll
            for (int j = 0; j < 8; ++j) { const int n = dir ? 127 - (step + j) : (step + j);
                u32x2 w; w.x = cvt_pk_bf16(s0, s1); w.y = cvt_pk_bf16(s2, s3); *(u32x2*)(ST + base + (size_t)n * 16384) = w;
                s0 = a * s0 + bf_lo(kv[j].x); s1 = a * s1 + bf_hi(kv[j].x); s2 = a * s2 + bf_lo(kv[j].y); s3 = a * s3 + bf_hi(kv[j].y); }
        }
    }
}

__device__ void phase_r3(const Params& p, LAS unsigned char* lds) {
    const int tid = threadIdx.x, wid = __builtin_amdgcn_readfirstlane(tid >> 6), lane = tid & 63, wr = wid >> 2, wc = wid & 3, fr = lane & 15, fq = lane >> 4;
    LAS bf16_t* Qs = (LAS bf16_t*)lds; LAS bf16_t* Ks = Qs + 128 * TS; LAS bf16_t* VT = Ks + 128 * TS; LAS bf16_t* Ss = VT + 128 * TS; LAS float* red = (LAS float*)(Ss + 128 * TS);
    const bf16_t* Qg = (const bf16_t*)(p.ws + WS_Q); const bf16_t* Kg = (const bf16_t*)(p.ws + WS_K); const bf16_t* Vg = (const bf16_t*)(p.ws + WS_V);
    const bf16_t* SG = (const bf16_t*)(p.ws + WS_SG); const bf16_t* ST = (const bf16_t*)(p.ws + WS_ST); bf16_t* BR0 = (bf16_t*)(p.ws + WS_BR);
    for (int unit = blockIdx.x; unit < 2048; unit += gridDim.x) {
        const int bh = unit >> 7, n = unit & 127, b = bh >> 3, h = bh & 7;
        const float lgf = log2_sigmoid(p.lg_f[h]), lgb = log2_sigmoid(p.lg_b[h]);
        const size_t rowbase = (size_t)b * SEQ + (size_t)n * 128;
        const bf16_t* Sf = ST + ((size_t)((0 * 16 + bh) * 128 + n)) * 16384; const bf16_t* Sb = ST + ((size_t)((1 * 16 + bh) * 128 + n)) * 16384;
        __syncthreads();
        stage_nat(Qs, Qg + rowbase * 1024 + h * 128, 1024, tid);
        stage_nat(Ks, Kg + rowbase * 1024 + h * 128, 1024, tid);
        stage_nat(Ss, Sf, 128, tid);
        { const int s = tid & 127, eg0 = tid >> 7;
#pragma unroll
          for (int it = 0; it < 4; ++it) { const int eg = eg0 + 4 * it;
              const u32x4 vw = *(const u32x4*)(Vg + (rowbase + s) * 1024 + h * 128 + eg * 8); const unsigned vv[4] = {vw.x, vw.y, vw.z, vw.w};
#pragma unroll
              for (int j = 0; j < 4; ++j) { const int r0 = (eg * 8 + 2 * j) * TS + s; VT[r0] = (bf16_t)(vv[j] & 0xffffu); VT[r0 + TS] = (bf16_t)(vv[j] >> 16); } } }
        __syncthreads();
        f32x4 accP[4][2], acc1[4][2], acc2[4][2];
        zero_acc(accP); mm128(accP, Qs, Ks, wr, wc, fr, fq);
#pragma unroll
        for (int m = 0; m < 4; ++m)
#pragma unroll
            for (int nn = 0; nn < 2; ++nn)
#pragma unroll
                for (int j = 0; j < 4; ++j) { const int t = 64 * wr + 16 * m + fr, s = 32 * wc + 16 * nn + 4 * fq + j; const int df = t - s;
                    accP[m][nn][j] *= (df >= 0) ? exp2f((float)df * lgf) : exp2f((float)(-df) * lgb); }
        zero_acc(acc1); mm128(acc1, Qs, Ss, wr, wc, fr, fq);
#pragma unroll
        for (int m = 0; m < 4; ++m) { const float sc = exp2f((float)(64 * wr + 16 * m + fr) * lgf);
#pragma unroll
            for (int nn = 0; nn < 2; ++nn) acc1[m][nn] *= sc; }
        __syncthreads();
#pragma unroll
        for (int m = 0; m < 4; ++m)
#pragma unroll
            for (int nn = 0; nn < 2; ++nn) { const int t = 64 * wr + 16 * m + fr, s = 32 * wc + 16 * nn + 4 * fq;
                u32x2 w; w.x = cvt_pk_bf16(accP[m][nn][0], accP[m][nn][1]); w.y = cvt_pk_bf16(accP[m][nn][2], accP[m][nn][3]);
                *(LAS u32x2*)(Ks + t * TS + s) = w; }
        stage_nat(Ss, Sb, 128, tid);
        __syncthreads();
        zero_acc(acc2); mm128(acc2, Qs, Ss, wr, wc, fr, fq);
#pragma unroll
        for (int m = 0; m < 4; ++m) { const float sc = exp2f((float)(127 - (64 * wr + 16 * m + fr)) * lgb);
#pragma unroll
            for (int nn = 0; nn < 2; ++nn) acc1[m][nn] += acc2[m][nn] * sc; }
        mm128(acc1, Ks, VT, wr, wc, fr, fq);
#pragma unroll
        for (int m = 0; m < 4; ++m) { float ss = 0.f;
#pragma unroll
            for (int nn = 0; nn < 2; ++nn) ss += (acc1[m][nn][0] * acc1[m][nn][0] + acc1[m][nn][1] * acc1[m][nn][1]) + (acc1[m][nn][2] * acc1[m][nn][2] + acc1[m][nn][3] * acc1[m][nn][3]);
            ss += __shfl_xor(ss, 16); ss += __shfl_xor(ss, 32);
            if (fq == 0) red[(64 * wr + 16 * m + fr) * 4 + wc] = ss; }
        __syncthreads();
#pragma unroll
        for (int m = 0; m < 4; ++m) { const int t = 64 * wr + 16 * m + fr; const f32x4 r4 = *(const LAS f32x4*)(red + t * 4);
            const float rstd = rsqrtf(((r4[0] + r4[1]) + (r4[2] + r4[3])) * (1.0f / 128.0f) + 1e-6f);
#pragma unroll
            for (int nn = 0; nn < 2; ++nn) { const int e0 = 32 * wc + 16 * nn + 4 * fq; const f32x4 gg = *(const f32x4*)(p.gn_gain + h * 128 + e0);
                const u32x2 sg = *(const u32x2*)(SG + (rowbase + t) * 1024 + h * 128 + e0);
                u32x2 w; w.x = cvt_pk_bf16(acc1[m][nn][0] * rstd * gg[0] * bf_lo(sg.x), acc1[m][nn][1] * rstd * gg[1] * bf_hi(sg.x));
                w.y = cvt_pk_bf16(acc1[m][nn][2] * rstd * gg[2] * bf_lo(sg.y), acc1[m][nn][3] * rstd * gg[3] * bf_hi(sg.y));
                *(u32x2*)(BR0 + (rowbase + t) * 1024 + h * 128 + e0) = w; } }
    }
}

__device__ void phase_final(const Params& p) {
    const int tid = threadIdx.x, lane = tid & 63, wv = tid >> 6; const float* SSQ = (const float*)(p.ws + WS_SSQ);
    f32x4 g[8];
#pragma unroll
    for (int i = 0; i < 8; ++i) g[i] = *(const f32x4*)(p.final_gain + i * 256 + lane * 4);
    for (int row = (blockIdx.x * 8 + wv) * 2; row < T_TOK; row += gridDim.x * 16) {
        float ss[2]; f32x4 y[2][8];
#pragma unroll
        for (int r = 0; r < 2; ++r) { ss[r] = lane < 32 ? SSQ[(size_t)(row + r) * 32 + lane] : 0.f;
#pragma unroll
            for (int i = 0; i < 8; ++i) y[r][i] = *(const f32x4*)(p.out + (size_t)(row + r) * DM + i * 256 + lane * 4); }
#pragma unroll
        for (int r = 0; r < 2; ++r) {
#pragma unroll
            for (int o = 32; o >= 1; o >>= 1) ss[r] += __shfl_xor(ss[r], o);
            const float rstd = rsqrtf(ss[r] * (1.0f / 2048.0f) + 1e-6f);
#pragma unroll
            for (int i = 0; i < 8; ++i) *(f32x4*)(p.out + (size_t)(row + r) * DM + i * 256 + lane * 4) = y[r][i] * rstd * g[i]; }
    }
}

__device__ __forceinline__ void grid_barrier(cg::grid_group& grid) {
    asm volatile("s_waitcnt vmcnt(0) lgkmcnt(0)" ::: "memory");
    grid.sync();
    __builtin_amdgcn_fence(__ATOMIC_ACQUIRE, "agent");
    asm volatile("s_waitcnt vmcnt(0)" ::: "memory");
}

__global__ void __launch_bounds__(512, 2) fwd_megakernel(Params p) {
    extern __shared__ __attribute__((aligned(16))) unsigned char lds_raw[];
    LAS unsigned char* lds = (LAS unsigned char*)lds_raw;
    cg::grid_group grid = cg::this_grid();
    unsigned char* ws = p.ws;
    const int G = gridDim.x, c = blockIdx.x;

#ifndef PHM
#define PHM 255
#endif
    if (PHM & 1) phase_prologue(p, lds);
    grid_barrier(grid);
    if (PHM & 2) {
        pg8::Gemm g{(const bf16_t*)(ws + WS_H), (const bf16_t*)(ws + WS_WIN), T_TOK, NCOL, 2048, 0, 0};
        pg8::Order S; S.init(T_TOK, NCOL, G, c, 0);
        Epi1 E{(bf16_t*)(ws + WS_Q), (bf16_t*)(ws + WS_K), (bf16_t*)(ws + WS_V), (bf16_t*)(ws + WS_SG), (bf16_t*)(ws + WS_UW), (bf16_t*)(ws + WS_GATE), (const float*)(ws + WS_COS), (const float*)(ws + WS_SIN)};
        pg8::gemm_phase<Epi1>(lds, g, S, E);
    }
    grid_barrier(grid);
    if (PHM & 4) phase_r1(p, lds);
    if (PHM & 4) phase_conv(p);
    grid_barrier(grid);
    if (PHM & 8) phase_scan(p);
    grid_barrier(grid);
    if (PHM & 16) phase_r3(p, lds);
    grid_barrier(grid);
    if (PHM & 32) {
        pg8::Gemm g{(const bf16_t*)(ws + WS_BR), (const bf16_t*)(ws + WS_WB), T_TOK, 2048, 1024, (size_t)T_TOK * 1024 * 2, (size_t)2048 * 1024 * 2};
        pg8::Order S; S.init(T_TOK, 2048, G, c, 1);
        Epi2 E{(const bf16_t*)(ws + WS_GATE), (bf16_t*)(ws + WS_MERGED)};
        pg8::gemm_phase<Epi2>(lds, g, S, E);
    }
    grid_barrier(grid);
    if (PHM & 64) {
        pg8::Gemm g{(const bf16_t*)(ws + WS_MERGED), (const bf16_t*)(ws + WS_WO), T_TOK, 2048, 2048, 0, 0};
        pg8::Order S; S.init(T_TOK, 2048, G, c, 0);
        Epi3 E{p.x, p.out, (float*)(ws + WS_SSQ)};
        pg8::gemm_phase<Epi3>(lds, g, S, E);
    }
    grid_barrier(grid);
    if (PHM & 128) phase_final(p);
}

extern "C" void kernel_launch(void* const* d_in, const int* in_sizes, int n_in, void* d_out, int out_size, void* d_ws, size_t ws_size, hipStream_t stream) {
    static int grid_blocks = 0;
    if (!grid_blocks) {
        if (n_in != 10 || out_size != T_TOK * DM || ws_size < WS_END) { fprintf(stderr, "kernel_launch: unexpected shapes (n_in %d out %d ws %zu)\n", n_in, out_size, ws_size); grid_blocks = -1; return; }
        int dev = 0, cus = 0, per_cu = 0;
        hipGetDevice(&dev);
        hipDeviceGetAttribute(&cus, hipDeviceAttributeMultiprocessorCount, dev);
        if (hipFuncSetAttribute((const void*)fwd_megakernel, hipFuncAttributeMaxDynamicSharedMemorySize, LDS_BYTES) != hipSuccess) { fprintf(stderr, "kernel_launch: hipFuncSetAttribute failed\n"); grid_blocks = -1; return; }
        hipOccupancyMaxActiveBlocksPerMultiprocessor(&per_cu, (const void*)fwd_megakernel, 512, LDS_BYTES);
        if (per_cu < 1) { fprintf(stderr, "kernel_launch: occupancy query says %d blocks per CU\n", per_cu); per_cu = 1; }
        grid_blocks = cus * per_cu;
    }
    if (grid_blocks < 0) return;
    Params p{};
    p.x = (const float*)d_in[0]; p.norm_gain = (const float*)d_in[1]; p.w_in = (const float*)d_in[2]; p.lg_f = (const float*)d_in[3]; p.lg_b = (const float*)d_in[4];
    p.gn_gain = (const float*)d_in[5]; p.conv_w = (const float*)d_in[6]; p.w_branch = (const float*)d_in[7]; p.w_out = (const float*)d_in[8]; p.final_gain = (const float*)d_in[9];
    p.out = (float*)d_out; p.ws = (unsigned char*)d_ws;
    void* args[] = {&p};
    hipError_t e = hipLaunchCooperativeKernel((const void*)fwd_megakernel, dim3(grid_blocks), dim3(512), args, LDS_BYTES, stream);
    if (e != hipSuccess) fprintf(stderr, "cooperative launch failed: %s (grid %d)\n", hipGetErrorString(e), grid_blocks);
}
```

```cpp
#include <hip/hip_runtime.h>
#include <hip/hip_cooperative_groups.h>
#include <cstdio>
namespace cg = cooperative_groups;

#define LAS __attribute__((address_space(3)))
typedef unsigned short bf16_t;
typedef short bf16x8 __attribute__((ext_vector_type(8)));
typedef float f32x4 __attribute__((ext_vector_type(4)));
typedef unsigned u32x4 __attribute__((ext_vector_type(4)));
typedef unsigned u32x2 __attribute__((ext_vector_type(2)));

constexpr int T_TOK = 32768, DM = 2048, SEQ = 16384, NCOL = 12288;
constexpr size_t MiB = 1ull << 20;
constexpr size_t WS_H = 0, WS_KV = 0, WS_WIN = 128 * MiB, WS_WB = 176 * MiB, WS_WO = 184 * MiB, WS_COS = 192 * MiB, WS_SIN = 196 * MiB,
                 WS_Q = 200 * MiB, WS_K = 264 * MiB, WS_MERGED = 200 * MiB, WS_V = 328 * MiB, WS_SG = 392 * MiB, WS_UW = 456 * MiB, WS_ST = 456 * MiB,
                 WS_GATE = 584 * MiB, WS_BR = 840 * MiB, WS_SSQ = 968 * MiB, WS_LG = 972 * MiB, WS_END = 973 * MiB;
constexpr int LDS_BYTES = 147456;
constexpr int TS = 136;

struct Params {
    const float* x; const float* norm_gain; const float* w_in; const float* lg_f; const float* lg_b; const float* gn_gain;
    const float* conv_w; const float* w_branch; const float* w_out; const float* final_gain; float* out; unsigned char* ws;
};

typedef __bf16 bf16x2_t __attribute__((ext_vector_type(2)));
typedef float f32x2_t __attribute__((ext_vector_type(2)));
__device__ __forceinline__ unsigned cvt_pk_bf16(float lo, float hi) { f32x2_t v = {lo, hi}; bf16x2_t b = __builtin_convertvector(v, bf16x2_t); return __builtin_bit_cast(unsigned, b); }
__device__ __forceinline__ bf16_t f2bf(float f) { unsigned u = __float_as_uint(f); u += 0x7FFFu + ((u >> 16) & 1u); return (bf16_t)(u >> 16); }
__device__ __forceinline__ float bf_lo(unsigned w) { return __uint_as_float(w << 16); }
__device__ __forceinline__ float bf_hi(unsigned w) { return __uint_as_float(w & 0xffff0000u); }
__device__ __forceinline__ float sigmoidf_(float x) { return __builtin_amdgcn_rcpf(1.0f + __expf(-x)); }
__device__ __forceinline__ float log2_sigmoid(float x) { return -log1pf(expf(-x)) * 1.4426950408889634f; }

namespace pg8 {
constexpr int BM = 256, BK = 64, HALF = 128, HTB = HALF * BK * 2, STAGE_BYTES = 8 * HTB, NXCD = 8, WGM = 8;
__host__ __device__ __forceinline__ int lds_byte(int r, int c) { const int st = (r >> 4) * 2 + (c >> 5), rr = r & 15, cc = c & 31, ob = rr * 64 + cc * 2; return st * 1024 + (ob ^ (((ob >> 9) & 1) << 5)); }
__host__ __device__ __forceinline__ void stage_rc(int b, int& R, int& C) { const int st = b / 1024, sb = b % 1024, swz = sb ^ (((sb >> 9) & 1) << 5); R = (st >> 1) * 16 + swz / 64; C = (st & 1) * 32 + (swz % 64) / 2; }
__host__ __device__ __forceinline__ int perm32(int rho) { const int n = rho >> 4, i = rho & 15; return 8 * (i >> 2) + 4 * n + (i & 3); }

struct Unit { int pm, pn, z; };
struct Gemm { const bf16_t* A; const bf16_t* Bt; int M, N, K; size_t zA, zB; };

struct Order {
    int nM, nN, nwg, G, c, zsh;
    __device__ void init(int M, int N, int G_, int c_, int zsh_) { nM = M / BM; nN = N / BM; nwg = nM * nN; G = G_; c = c_; zsh = zsh_; }
    __device__ bool next(int i, Unit& u) const {
        const int ti = i >> zsh; u.z = i & ((1 << zsh) - 1);
        const long L = (long)ti * G + c; if (L >= nwg) return false;
        int wgid = (int)L; { const int q = nwg / NXCD, r = nwg % NXCD, xcd = wgid % NXCD, off = wgid / NXCD; wgid = (xcd < r ? xcd * (q + 1) : r * (q + 1) + (xcd - r) * q) + off; }
        const int nig = WGM * nN, gid = wgid / nig, fm = gid * WGM, gsz = (nM - fm) < WGM ? (nM - fm) : WGM;
        u.pm = fm + ((wgid % nig) % gsz); u.pn = (wgid % nig) / gsz; return true;
    }
};

template <class Epi>
__device__ __forceinline__ void gemm_phase(LAS unsigned char* lds, const Gemm g, const Order& S, const Epi& E) {
    const int tid = threadIdx.x, wid = __builtin_amdgcn_readfirstlane(tid >> 6), lane = tid & 63, wr = wid >> 2, wc = wid & 3, fr = lane & 15, fq = lane >> 4;
    const int K = g.K, nt = K / BK;
    unsigned voffA[2], voffB[2];
#pragma unroll
    for (int i = 0; i < 2; ++i) { int R, C; stage_rc(tid * 16 + i * 8192, R, C); const int Rb = Epi::PERM ? ((R & ~31) + perm32(R & 31)) : R;
        voffA[i] = (unsigned)(R * K + C) * 2u; voffB[i] = (unsigned)(Rb * K + C) * 2u; }
    const size_t kstep = (size_t)(BK * 2);
    const size_t hstep = (size_t)HALF * K * 2;
    const size_t tstep = 2 * hstep;
    const unsigned ldsw = (unsigned)wid * 1024u;
    const int aoff = lds_byte(wr * 64 + fr, fq * 8), boff = lds_byte(wc * 32 + fr, fq * 8);
#define PG8_SA(b, h) (((b) * 2 + (h)) * HTB)
#define PG8_SB(b, h) ((4 + (b) * 2 + (h)) * HTB)
#define PG8_STAGE(bufoff, gbase, voff) do { _Pragma("unroll") for (int _i = 0; _i < 2; ++_i) \
        __builtin_amdgcn_global_load_lds((const unsigned*)((const char*)(gbase) + (voff)[_i]), (LAS unsigned*)(lds + (bufoff) + ldsw + _i * 8192), 16, 0, 0); } while (0)
#define PG8_LDA(dst, b, h) do { _Pragma("unroll") for (int m = 0; m < 4; ++m) _Pragma("unroll") for (int k = 0; k < 2; ++k) dst[m][k] = *(const LAS bf16x8*)(lds + PG8_SA(b, h) + aoff + m * 2048 + k * 1024); } while (0)
#define PG8_LDB(dst, b, h) do { _Pragma("unroll") for (int n = 0; n < 2; ++n) _Pragma("unroll") for (int k = 0; k < 2; ++k) dst[n][k] = *(const LAS bf16x8*)(lds + PG8_SB(b, h) + boff + n * 2048 + k * 1024); } while (0)
#define PG8_MMA(ai, bj, At, Bt) do { __builtin_amdgcn_s_setprio(1); _Pragma("unroll") for (int m = 0; m < 4; ++m) _Pragma("unroll") for (int n = 0; n < 2; ++n) _Pragma("unroll") for (int k = 0; k < 2; ++k) \
        acc[ai][bj][m][n] = __builtin_amdgcn_mfma_f32_16x16x32_bf16(Bt[n][k], At[m][k], acc[ai][bj][m][n], 0, 0, 0); __builtin_amdgcn_s_setprio(0); } while (0)
#define PG8_WAIT_V(n) asm volatile("s_waitcnt vmcnt(" #n ")" ::: "memory")
#define PG8_WAIT_L(n) asm volatile("s_waitcnt lgkmcnt(" #n ")" ::: "memory")
#define PG8_BAR __builtin_amdgcn_s_barrier()
#define PG8_SCHED __builtin_amdgcn_sched_barrier(0)
    Unit cur, nxt; int ui = 0;
    if (!S.next(0, cur)) return;
    f32x4 acc[2][2][4][2];
#pragma unroll
    for (int a = 0; a < 2; ++a)
#pragma unroll
        for (int b = 0; b < 2; ++b)
#pragma unroll
            for (int m = 0; m < 4; ++m)
#pragma unroll
                for (int n = 0; n < 2; ++n) acc[a][b][m][n] = (f32x4){0.f, 0.f, 0.f, 0.f};
    bf16x8 At[4][2], B0[2][2], B1[2][2];
    const char* cA = (const char*)g.A + (size_t)cur.pm * tstep + (size_t)cur.z * g.zA; const char* cB = (const char*)g.Bt + (size_t)cur.pn * tstep + (size_t)cur.z * g.zB;
    PG8_STAGE(PG8_SB(0, 0), cB, voffB); PG8_STAGE(PG8_SA(0, 0), cA, voffA); PG8_STAGE(PG8_SB(0, 1), cB + hstep, voffB); PG8_STAGE(PG8_SA(0, 1), cA + hstep, voffA);
    if (wr == 1) PG8_BAR;
    PG8_WAIT_V(4); PG8_BAR;
    PG8_STAGE(PG8_SB(1, 0), cB + kstep, voffB); PG8_STAGE(PG8_SA(1, 0), cA + kstep, voffA); PG8_STAGE(PG8_SB(1, 1), cB + hstep + kstep, voffB);
    PG8_WAIT_V(6); PG8_BAR;
    for (;;) {
        const bool has_next = S.next(ui + 1, nxt);
        const char* nA = has_next ? (const char*)g.A + (size_t)nxt.pm * tstep + (size_t)nxt.z * g.zA : cA;
        const char* nB = has_next ? (const char*)g.Bt + (size_t)nxt.pn * tstep + (size_t)nxt.z * g.zB : cB;
        for (int t = 0; t < nt; t += 2) {
            const bool last = (t == nt - 2);
            const char* a1 = cA + (size_t)(t + 1) * kstep;
            const char* a2 = last ? nA : cA + (size_t)(t + 2) * kstep; const char* b2 = last ? nB : cB + (size_t)(t + 2) * kstep;
            const char* a3 = a2 + kstep; const char* b3 = b2 + kstep;
            PG8_LDB(B0, 0, 0); PG8_SCHED; PG8_LDA(At, 0, 0); PG8_STAGE(PG8_SA(1, 1), a1 + hstep, voffA);
            PG8_WAIT_L(8); PG8_BAR; PG8_WAIT_L(0); PG8_MMA(0, 0, At, B0); PG8_BAR; PG8_SCHED;
            PG8_LDB(B1, 0, 1); PG8_STAGE(PG8_SB(0, 0), b2, voffB);
            PG8_BAR; PG8_WAIT_L(0); PG8_MMA(0, 1, At, B1); PG8_BAR;
            PG8_LDA(At, 0, 1); PG8_STAGE(PG8_SA(0, 0), a2, voffA);
            PG8_BAR; PG8_WAIT_L(0); PG8_MMA(1, 0, At, B0); PG8_BAR; PG8_SCHED;
            PG8_STAGE(PG8_SB(0, 1), b2 + hstep, voffB);
            PG8_WAIT_V(6); PG8_BAR; PG8_MMA(1, 1, At, B1); PG8_BAR;
            PG8_LDB(B0, 1, 0); PG8_SCHED; PG8_LDA(At, 1, 0); PG8_STAGE(PG8_SA(0, 1), a2 + hstep, voffA);
            PG8_WAIT_L(8); PG8_BAR; PG8_WAIT_L(0); PG8_MMA(0, 0, At, B0); PG8_BAR; PG8_SCHED;
            PG8_LDB(B1, 1, 1); PG8_STAGE(PG8_SB(1, 0), b3, voffB);
            PG8_BAR; PG8_WAIT_L(0); PG8_MMA(0, 1, At, B1); PG8_BAR;
            PG8_LDA(At, 1, 1); PG8_STAGE(PG8_SA(1, 0), a3, voffA);
            PG8_BAR; PG8_WAIT_L(0); PG8_MMA(1, 0, At, B0); PG8_BAR; PG8_SCHED;
            PG8_STAGE(PG8_SB(1, 1), b3 + hstep, voffB);
            PG8_WAIT_V(6); PG8_BAR; PG8_MMA(1, 1, At, B1); PG8_BAR;
        }
        E(acc, cur, wr, wc, fr, fq);
        if (!has_next) break;
#pragma unroll
        for (int a = 0; a < 2; ++a)
#pragma unroll
            for (int b = 0; b < 2; ++b)
#pragma unroll
                for (int m = 0; m < 4; ++m)
#pragma unroll
                    for (int n = 0; n < 2; ++n) acc[a][b][m][n] = (f32x4){0.f, 0.f, 0.f, 0.f};
        cur = nxt; cA = nA; cB = nB; ++ui;
    }
    PG8_WAIT_V(0);
    if (wr == 0) PG8_BAR;
    PG8_BAR;
#undef PG8_SA
#undef PG8_SB
#undef PG8_STAGE
#undef PG8_LDA
#undef PG8_LDB
#undef PG8_MMA
#undef PG8_WAIT_V
#undef PG8_WAIT_L
#undef PG8_BAR
#undef PG8_SCHED
}
}

struct Epi1 {
    static constexpr bool PERM = true;
    bf16_t *Q, *K, *V, *SG, *UW, *GATE; const float *COS, *SIN;
    __device__ __forceinline__ void operator()(const f32x4 (&acc)[2][2][4][2], const pg8::Unit& u, int wr, int wc, int fr, int fq) const {
        const int row0 = u.pm * 256 + wr * 64 + fr, lc = wc * 32 + 8 * fq, pn = u.pn;
        if (pn < 8) {
            bf16_t* base = (pn < 4 ? Q : K) + (pn & 3) * 256 + lc;
            const int i0 = lc >> 1;
#pragma unroll
            for (int ai = 0; ai < 2; ++ai) {
                f32x4 cs[4], sn[4];
#pragma unroll
                for (int m = 0; m < 4; ++m) { const int pos = (row0 + ai * 128 + m * 16) & (SEQ - 1);
                    cs[m] = *(const f32x4*)(COS + pos * 64 + i0); sn[m] = *(const f32x4*)(SIN + pos * 64 + i0); }
#pragma unroll
                for (int m = 0; m < 4; ++m) {
                    const int row = row0 + ai * 128 + m * 16;
#pragma unroll
                    for (int bj = 0; bj < 2; ++bj) {
                        const f32x4 v0 = acc[ai][bj][m][0], v1 = acc[ai][bj][m][1]; u32x4 w;
                        w.x = cvt_pk_bf16(v0[0] * cs[m][0] - v0[1] * sn[m][0], v0[1] * cs[m][0] + v0[0] * sn[m][0]);
                        w.y = cvt_pk_bf16(v0[2] * cs[m][1] - v0[3] * sn[m][1], v0[3] * cs[m][1] + v0[2] * sn[m][1]);
                        w.z = cvt_pk_bf16(v1[0] * cs[m][2] - v1[1] * sn[m][2], v1[1] * cs[m][2] + v1[0] * sn[m][2]);
                        w.w = cvt_pk_bf16(v1[2] * cs[m][3] - v1[3] * sn[m][3], v1[3] * cs[m][3] + v1[2] * sn[m][3]);
                        *(u32x4*)(base + (size_t)row * 1024 + bj * 128) = w; }
                }
            }
        } else if (pn < 16) {
            const bool act = pn >= 12;
            bf16_t* base = (act ? SG : V) + (pn & 3) * 256 + lc;
#pragma unroll
            for (int ai = 0; ai < 2; ++ai)
#pragma unroll
                for (int m = 0; m < 4; ++m) {
                    const int row = row0 + ai * 128 + m * 16;
#pragma unroll
                    for (int bj = 0; bj < 2; ++bj) {
                        f32x4 v0 = acc[ai][bj][m][0], v1 = acc[ai][bj][m][1];
                        if (act) {
#pragma unroll
                            for (int j = 0; j < 4; ++j) { v0[j] = v0[j] * sigmoidf_(v0[j]); v1[j] = v1[j] * sigmoidf_(v1[j]); } }
                        u32x4 w; w.x = cvt_pk_bf16(v0[0], v0[1]); w.y = cvt_pk_bf16(v0[2], v0[3]); w.z = cvt_pk_bf16(v1[0], v1[1]); w.w = cvt_pk_bf16(v1[2], v1[3]);
                        *(u32x4*)(base + (size_t)row * 1024 + bj * 128) = w; }
                }
        } else if (pn < 32) {
            const int ch0 = 64 * (pn - 16) + 16 * wc + 4 * fq;
#pragma unroll
            for (int ai = 0; ai < 2; ++ai)
#pragma unroll
                for (int m = 0; m < 4; ++m) {
                    const int row = row0 + ai * 128 + m * 16;
                    const f32x4 cc = acc[ai][0][m][0], cx = acc[ai][0][m][1], cb = acc[ai][1][m][0], g = acc[ai][1][m][1];
                    u32x4 w;
                    w.x = cvt_pk_bf16(cc[0] * cx[0], cb[0] * g[0] * sigmoidf_(g[0]));
                    w.y = cvt_pk_bf16(cc[1] * cx[1], cb[1] * g[1] * sigmoidf_(g[1]));
                    w.z = cvt_pk_bf16(cc[2] * cx[2], cb[2] * g[2] * sigmoidf_(g[2]));
                    w.w = cvt_pk_bf16(cc[3] * cx[3], cb[3] * g[3] * sigmoidf_(g[3]));
                    *(u32x4*)(UW + ((size_t)row * 1024 + ch0) * 2) = w;
                }
        } else {
            bf16_t* base = GATE + (pn - 32) * 256 + lc;
#pragma unroll
            for (int ai = 0; ai < 2; ++ai)
#pragma unroll
                for (int m = 0; m < 4; ++m) {
                    const int row = row0 + ai * 128 + m * 16;
#pragma unroll
                    for (int bj = 0; bj < 2; ++bj) {
                        const f32x4 v0 = acc[ai][bj][m][0], v1 = acc[ai][bj][m][1];
                        u32x4 w; w.x = cvt_pk_bf16(sigmoidf_(v0[0]), sigmoidf_(v0[1])); w.y = cvt_pk_bf16(sigmoidf_(v0[2]), sigmoidf_(v0[3]));
                        w.z = cvt_pk_bf16(sigmoidf_(v1[0]), sigmoidf_(v1[1])); w.w = cvt_pk_bf16(sigmoidf_(v1[2]), sigmoidf_(v1[3]));
                        *(u32x4*)(base + (size_t)row * 4096 + bj * 128) = w; }
                }
        }
    }
};

struct Epi2 {
    static constexpr bool PERM = true;
    const bf16_t* GATE; bf16_t* MERGED;
    __device__ __forceinline__ void operator()(const f32x4 (&acc)[2][2][4][2], const pg8::Unit& u, int wr, int wc, int fr, int fq) const {
        const int row0 = u.pm * 256 + wr * 64 + fr, col = u.pn * 256 + wc * 32 + 8 * fq;
#pragma unroll
        for (int ai = 0; ai < 2; ++ai) {
            u32x4 gw[4][2], pw[4][2];
#pragma unroll
            for (int m = 0; m < 4; ++m)
#pragma unroll
                for (int bj = 0; bj < 2; ++bj) { const int row = row0 + ai * 128 + m * 16;
                    gw[m][bj] = *(const u32x4*)(GATE + (size_t)row * 4096 + u.z * 2048 + col + bj * 128);
                    pw[m][bj] = u.z ? *(const u32x4*)(MERGED + (size_t)row * 2048 + col + bj * 128) : (u32x4){0u, 0u, 0u, 0u}; }
#pragma unroll
            for (int m = 0; m < 4; ++m)
#pragma unroll
                for (int bj = 0; bj < 2; ++bj) { const int row = row0 + ai * 128 + m * 16;
                    const u32x4 g = gw[m][bj], pv = pw[m][bj]; const f32x4 v0 = acc[ai][bj][m][0], v1 = acc[ai][bj][m][1];
                    u32x4 w;
                    w.x = cvt_pk_bf16(bf_lo(g.x) * v0[0] + bf_lo(pv.x), bf_hi(g.x) * v0[1] + bf_hi(pv.x));
                    w.y = cvt_pk_bf16(bf_lo(g.y) * v0[2] + bf_lo(pv.y), bf_hi(g.y) * v0[3] + bf_hi(pv.y));
                    w.z = cvt_pk_bf16(bf_lo(g.z) * v1[0] + bf_lo(pv.z), bf_hi(g.z) * v1[1] + bf_hi(pv.z));
                    w.w = cvt_pk_bf16(bf_lo(g.w) * v1[2] + bf_lo(pv.w), bf_hi(g.w) * v1[3] + bf_hi(pv.w));
                    *(u32x4*)(MERGED + (size_t)row * 2048 + col + bj * 128) = w; }
        }
    }
};

struct Epi3 {
    static constexpr bool PERM = false;
    const float* X; float* OUT; float* SSQ;
    __device__ __forceinline__ void operator()(const f32x4 (&acc)[2][2][4][2], const pg8::Unit& u, int wr, int wc, int fr, int fq) const {
        const int row0 = u.pm * 256 + wr * 64 + fr, col0 = u.pn * 256 + wc * 32 + 4 * fq;
#pragma unroll
        for (int ai = 0; ai < 2; ++ai) {
            f32x4 xv[4][2][2];
#pragma unroll
            for (int m = 0; m < 4; ++m)
#pragma unroll
                for (int bj = 0; bj < 2; ++bj)
#pragma unroll
                    for (int n = 0; n < 2; ++n) xv[m][bj][n] = *(const f32x4*)(X + (size_t)(row0 + ai * 128 + m * 16) * 2048 + col0 + bj * 128 + n * 16);
#pragma unroll
            for (int m = 0; m < 4; ++m) {
                const int row = row0 + ai * 128 + m * 16; const size_t off = (size_t)row * 2048 + col0; float ss = 0.f;
#pragma unroll
                for (int bj = 0; bj < 2; ++bj)
#pragma unroll
                    for (int n = 0; n < 2; ++n) { const f32x4 y = xv[m][bj][n] + acc[ai][bj][m][n];
                        *(f32x4*)(OUT + off + bj * 128 + n * 16) = y; ss += (y[0] * y[0] + y[1] * y[1]) + (y[2] * y[2] + y[3] * y[3]); }
                ss += __shfl_xor(ss, 16); ss += __shfl_xor(ss, 32);
                if (fq == 0) SSQ[(size_t)row * 32 + u.pn * 4 + wc] = ss;
            }
        }
    }
};

__device__ __forceinline__ int win_src_col(int c, float& scale) {
    scale = 1.0f;
    if (c < 2048) { const int p = c & 127; if (c >= 1024) scale = 0.08838834764831845f; return (c & ~127) + (p >> 1) + 64 * (p & 1); }
    if (c < 4096 || c >= 8192) return c;
    const int l = (c - 4096) & 255, ct = (c - 4096) >> 8, bj = l >> 7, rem = l & 127, wc = rem >> 5, fq = (rem & 31) >> 3, j8 = rem & 7;
    const int ch = 64 * ct + 16 * wc + 4 * fq + (j8 & 3);
    const int qty = bj == 0 ? (j8 < 4 ? 1 : 2) : (j8 < 4 ? 0 : 3);
    return 4096 + qty * 1024 + ch;
}

__device__ void phase_prologue(const Params& p, LAS unsigned char* lds) {
    const int tid = threadIdx.x, G = gridDim.x;
    unsigned char* ws = p.ws;
    if (blockIdx.x == 0 && tid < 16) ((float*)(ws + WS_LG))[tid] = log2_sigmoid(tid < 8 ? p.lg_f[tid] : p.lg_b[tid - 8]);
    LAS float* tile = (LAS float*)lds;
    for (int tix = blockIdx.x; tix < 8192; tix += G) {
        const float* src; bf16_t* dst; int ld, Kd, n0, k0; bool isin = false;
        if (tix < 6144) { src = p.w_in; dst = (bf16_t*)(ws + WS_WIN); ld = NCOL; Kd = 2048; n0 = (tix >> 5) * 64; k0 = (tix & 31) * 64; isin = true; }
        else if (tix < 7168) { const int t = tix - 6144, z = t >> 9, tt = t & 511; src = p.w_branch + (size_t)z * 1024 * 2048; dst = (bf16_t*)(ws + WS_WB) + (size_t)z * 2048 * 1024; ld = 2048; Kd = 1024; n0 = (tt >> 4) * 64; k0 = (tt & 15) * 64; }
        else { const int t = tix - 7168; src = p.w_out; dst = (bf16_t*)(ws + WS_WO); ld = 2048; Kd = 2048; n0 = (t >> 5) * 64; k0 = (t & 31) * 64; }
        __syncthreads();
        { const int nn = tid & 63, kk0 = tid >> 6; float sc = 1.0f; const int scol = isin ? win_src_col(n0 + nn, sc) : (n0 + nn);
#pragma unroll
          for (int it = 0; it < 8; ++it) { const int kk = kk0 + 8 * it; tile[kk * 65 + nn] = src[(size_t)(k0 + kk) * ld + scol] * sc; } }
        __syncthreads();
        { const int nn = tid >> 3, kq = tid & 7; float v[8];
#pragma unroll
          for (int j = 0; j < 8; ++j) v[j] = tile[(kq * 8 + j) * 65 + nn];
          u32x4 w; w.x = cvt_pk_bf16(v[0], v[1]); w.y = cvt_pk_bf16(v[2], v[3]); w.z = cvt_pk_bf16(v[4], v[5]); w.w = cvt_pk_bf16(v[6], v[7]);
          *(u32x4*)(dst + (size_t)(n0 + nn) * Kd + k0 + kq * 8) = w; }
    }
    {
        float* COS = (float*)(ws + WS_COS); float* SIN = (float*)(ws + WS_SIN);
        for (int idx = blockIdx.x * 512 + tid; idx < SEQ * 64; idx += G * 512) {
            const int pos = idx >> 6, i = idx & 63;
            const float invf = (float)exp2(-(double)i * (13.287712379549449 / 64.0));
            const float angf = (float)pos * invf;
            const double a = (double)angf;
            const double n = rint(a * 0.15915494309189535);
            double r = fma(-n, 6.283185307179586, a); r = fma(-n, 2.4492935982947064e-16, r);
            const double qd = rint(r * 0.6366197723675814); const int q = (int)qd;
            double y = fma(-qd, 1.5707963267948966, r); y = fma(-qd, 6.123233995736766e-17, y);
            const double y2 = y * y;
            double sp = -2.5052108385441720e-08; sp = fma(sp, y2, 2.7557319223985893e-06); sp = fma(sp, y2, -1.9841269841269841e-04); sp = fma(sp, y2, 8.3333333333333332e-03); sp = fma(sp, y2, -1.6666666666666666e-01);
            const double sy = fma(y * y2, sp, y);
            double cp = 2.0876756987868099e-09; cp = fma(cp, y2, -2.7557319223985888e-07); cp = fma(cp, y2, 2.4801587301587302e-05); cp = fma(cp, y2, -1.3888888888888889e-03); cp = fma(cp, y2, 4.1666666666666664e-02); cp = fma(cp, y2, -0.5);
            const double cy = fma(y2, cp, 1.0);
            double s, c;
            switch (q & 3) { case 0: s = sy; c = cy; break; case 1: s = cy; c = -sy; break; case 2: s = -sy; c = -cy; break; default: s = -cy; c = sy; break; }
            COS[idx] = (float)c; SIN[idx] = (float)s;
        }
    }
    {
        bf16_t* H = (bf16_t*)(ws + WS_H); const int lane = tid & 63, wv = tid >> 6;
        f32x4 gn[8];
#pragma unroll
        for (int i = 0; i < 8; ++i) gn[i] = *(const f32x4*)(p.norm_gain + i * 256 + lane * 4);
        for (int row = (blockIdx.x * 8 + wv) * 2; row < T_TOK; row += G * 16) {
            f32x4 v[2][8]; float ss[2] = {0.f, 0.f};
#pragma unroll
            for (int r = 0; r < 2; ++r)
#pragma unroll
                for (int i = 0; i < 8; ++i) v[r][i] = *(const f32x4*)(p.x + (size_t)(row + r) * DM + i * 256 + lane * 4);
#pragma unroll
            for (int r = 0; r < 2; ++r) {
#pragma unroll
                for (int i = 0; i < 8; ++i) ss[r] += (v[r][i][0] * v[r][i][0] + v[r][i][1] * v[r][i][1]) + (v[r][i][2] * v[r][i][2] + v[r][i][3] * v[r][i][3]);
#pragma unroll
                for (int o = 32; o >= 1; o >>= 1) ss[r] += __shfl_xor(ss[r], o);
                const float rstd = rsqrtf(ss[r] * (1.0f / 2048.0f) + 1e-6f);
#pragma unroll
                for (int i = 0; i < 8; ++i) {
                    u32x2 w; w.x = cvt_pk_bf16(v[r][i][0] * rstd * gn[i][0], v[r][i][1] * rstd * gn[i][1]); w.y = cvt_pk_bf16(v[r][i][2] * rstd * gn[i][2], v[r][i][3] * rstd * gn[i][3]);
                    *(u32x2*)(H + (size_t)(row + r) * DM + i * 256 + lane * 4) = w; }
            }
        }
    }
}

__device__ __forceinline__ void mm128(f32x4 (&acc)[4][2], const LAS bf16_t* At, const LAS bf16_t* Bt, int wr, int wc, int fr, int fq) {
    __builtin_amdgcn_sched_barrier(0);
#pragma unroll 1
    for (int kb = 0; kb < 4; ++kb) {
        bf16x8 a[4], b[2];
#pragma unroll
        for (int m = 0; m < 4; ++m) a[m] = *(const LAS bf16x8*)(At + (64 * wr + 16 * m + fr) * TS + kb * 32 + fq * 8);
#pragma unroll
        for (int n = 0; n < 2; ++n) b[n] = *(const LAS bf16x8*)(Bt + (32 * wc + 16 * n + fr) * TS + kb * 32 + fq * 8);
#pragma unroll
        for (int m = 0; m < 4; ++m)
#pragma unroll
            for (int n = 0; n < 2; ++n) acc[m][n] = __builtin_amdgcn_mfma_f32_16x16x32_bf16(b[n], a[m], acc[m][n], 0, 0, 0);
    }
}
__device__ __forceinline__ void zero_acc(f32x4 (&acc)[4][2]) {
#pragma unroll
    for (int m = 0; m < 4; ++m)
#pragma unroll
        for (int n = 0; n < 2; ++n) acc[m][n] = (f32x4){0.f, 0.f, 0.f, 0.f};
}
__device__ __forceinline__ void stage_nat(LAS bf16_t* dst, const bf16_t* src, size_t ld, int tid) {
#pragma unroll
    for (int it = 0; it < 4; ++it) { const int idx = tid + 512 * it, row = idx >> 4, cg8 = idx & 15;
        const u32x4 v = *(const u32x4*)(src + (size_t)row * ld + cg8 * 8); *(LAS u32x4*)(dst + row * TS + cg8 * 8) = v; }
}

__device__ void phase_r1(const Params& p, LAS unsigned char* lds) {
    const int tid = threadIdx.x, wid = __builtin_amdgcn_readfirstlane(tid >> 6), lane = tid & 63, wr = wid >> 2, wc = wid & 3, fr = lane & 15, fq = lane >> 4;
    LAS bf16_t* VT = (LAS bf16_t*)lds; LAS bf16_t* KfT = VT + 128 * TS; LAS bf16_t* KbT = KfT + 128 * TS;
    const bf16_t* Kg = (const bf16_t*)(p.ws + WS_K); const bf16_t* Vg = (const bf16_t*)(p.ws + WS_V); bf16_t* KV = (bf16_t*)(p.ws + WS_KV);
    for (int unit = blockIdx.x; unit < 2048; unit += gridDim.x) {
        const int bh = unit >> 7, n = unit & 127, b = bh >> 3, h = bh & 7;
        const float lgf = ((const float*)(p.ws + WS_LG))[h], lgb = ((const float*)(p.ws + WS_LG))[8 + h];
        const size_t rowbase = (size_t)b * SEQ + (size_t)n * 128;
        __syncthreads();
        { const int s = tid & 127, eg0 = tid >> 7;
          const float wf = exp2f((float)(128 - s) * lgf), wb = exp2f((float)(s + 1) * lgb);
#pragma unroll
          for (int it = 0; it < 4; ++it) { const int eg = eg0 + 4 * it;
              const u32x4 kw = *(const u32x4*)(Kg + (rowbase + s) * 1024 + h * 128 + eg * 8);
              const u32x4 vw = *(const u32x4*)(Vg + (rowbase + s) * 1024 + h * 128 + eg * 8);
              const unsigned kk[4] = {kw.x, kw.y, kw.z, kw.w}, vv[4] = {vw.x, vw.y, vw.z, vw.w};
#pragma unroll
              for (int j = 0; j < 4; ++j) { const float k0 = bf_lo(kk[j]), k1 = bf_hi(kk[j]); const int r0 = (eg * 8 + 2 * j) * TS + s, r1 = r0 + TS;
                  KfT[r0] = f2bf(k0 * wf); KfT[r1] = f2bf(k1 * wf); KbT[r0] = f2bf(k0 * wb); KbT[r1] = f2bf(k1 * wb);
                  VT[r0] = (bf16_t)(vv[j] & 0xffffu); VT[r1] = (bf16_t)(vv[j] >> 16); } } }
        __syncthreads();
#pragma unroll
        for (int dir = 0; dir < 2; ++dir) {
            f32x4 acc[4][2]; zero_acc(acc);
            mm128(acc, VT, dir ? KbT : KfT, wr, wc, fr, fq);
            bf16_t* dst = KV + ((size_t)((dir * 16 + bh) * 128 + n)) * 16384;
#pragma unroll
            for (int m = 0; m < 4; ++m)
#pragma unroll
                for (int nn = 0; nn < 2; ++nn) { const int e = 64 * wr + 16 * m + fr, d = 32 * wc + 16 * nn + 4 * fq;
                    u32x2 w; w.x = cvt_pk_bf16(acc[m][nn][0], acc[m][nn][1]); w.y = cvt_pk_bf16(acc[m][nn][2], acc[m][nn][3]);
                    *(u32x2*)(dst + e * 128 + d) = w; }
        }
    }
}

__device__ void phase_conv(const Params& p) {
    const int tid = threadIdx.x; const int cg4 = tid & 255, half = tid >> 8;
    const unsigned* UW = (const unsigned*)(p.ws + WS_UW); bf16_t* BR1 = (bf16_t*)(p.ws + WS_BR) + (size_t)T_TOK * 1024;
    const f32x4 k0 = *(const f32x4*)(p.conv_w + cg4 * 4), k1 = *(const f32x4*)(p.conv_w + 1024 + cg4 * 4), k2 = *(const f32x4*)(p.conv_w + 2048 + cg4 * 4);
    for (int unit = blockIdx.x; unit < 512; unit += gridDim.x) {
        const int tb = unit * 64 + half * 32;
        for (int bt = 0; bt < 4; ++bt) {
            const int t0 = tb + bt * 8;
            u32x4 r[10];
#pragma unroll
            for (int j = 0; j < 10; ++j) {
                const bool valid = !((j == 0 && (t0 & (SEQ - 1)) == 0) || (j == 9 && ((t0 + 8) & (SEQ - 1)) == 0));
                r[j] = valid ? *(const u32x4*)(UW + (size_t)(t0 - 1 + j) * 1024 + cg4 * 4) : (u32x4){0u, 0u, 0u, 0u}; }
#pragma unroll
            for (int i = 0; i < 8; ++i) {
                const u32x4 prev = r[i], cur = r[i + 1], nxt = r[i + 2];
                const float c0 = k0[0] * bf_lo(prev.x) + k1[0] * bf_lo(cur.x) + k2[0] * bf_lo(nxt.x);
                const float c1 = k0[1] * bf_lo(prev.y) + k1[1] * bf_lo(cur.y) + k2[1] * bf_lo(nxt.y);
                const float c2 = k0[2] * bf_lo(prev.z) + k1[2] * bf_lo(cur.z) + k2[2] * bf_lo(nxt.z);
                const float c3 = k0[3] * bf_lo(prev.w) + k1[3] * bf_lo(cur.w) + k2[3] * bf_lo(nxt.w);
                u32x2 w; w.x = cvt_pk_bf16(c0 * bf_hi(cur.x), c1 * bf_hi(cur.y)); w.y = cvt_pk_bf16(c2 * bf_hi(cur.z), c3 * bf_hi(cur.w));
                *(u32x2*)(BR1 + (size_t)(t0 + i) * 1024 + cg4 * 4) = w;
            }
        }
    }
}

__device__ void phase_scan(const Params& p) {
    const int tid = threadIdx.x;
    const bf16_t* KV = (const bf16_t*)(p.ws + WS_KV); bf16_t* ST = (bf16_t*)(p.ws + WS_ST);
    for (int item = blockIdx.x * 512 + tid; item < 131072; item += gridDim.x * 512) {
        const int q = item & 4095, bh = (item >> 12) & 15, dir = item >> 16, h = bh & 7;
        const float lg = ((const float*)(p.ws + WS_LG))[dir * 8 + h];
        const float a = exp2f(128.0f * lg);
        const size_t base = (size_t)((dir * 16 + bh) * 128) * 16384 + (size_t)q * 4;
        float s0 = 0.f, s1 = 0.f, s2 = 0.f, s3 = 0.f;
        for (int step = 0; step < 128; step += 8) {
            u32x2 kv[8];
#pragma unroll
            for (int j = 0; j < 8; ++j) { const int n = dir ? 127 - (step + j) : (step + j); kv[j] = *(const u32x2*)(KV + base + (size_t)n * 16384); }
#pragma unroll
            for (int j = 0; j < 8; ++j) { const int n = dir ? 127 - (step + j) : (step + j);
                u32x2 w; w.x = cvt_pk_bf16(s0, s1); w.y = cvt_pk_bf16(s2, s3); *(u32x2*)(ST + base + (size_t)n * 16384) = w;
                s0 = a * s0 + bf_lo(kv[j].x); s1 = a * s1 + bf_hi(kv[j].x); s2 = a * s2 + bf_lo(kv[j].y); s3 = a * s3 + bf_hi(kv[j].y); }
        }
    }
}

__device__ __forceinline__ void ld_nat(u32x4 (&r)[4], const bf16_t* src, size_t ld, int tid) {
#pragma unroll
    for (int it = 0; it < 4; ++it) { const int idx = tid + 512 * it, row = idx >> 4, cg8 = idx & 15; r[it] = *(const u32x4*)(src + (size_t)row * ld + cg8 * 8); }
}
__device__ __forceinline__ void st_nat(LAS bf16_t* dst, const u32x4 (&r)[4], int tid) {
#pragma unroll
    for (int it = 0; it < 4; ++it) { const int idx = tid + 512 * it, row = idx >> 4, cg8 = idx & 15; *(LAS u32x4*)(dst + row * TS + cg8 * 8) = r[it]; }
}
__device__ __forceinline__ void ld_tr(u32x4 (&r)[4], const bf16_t* src, int tid) {
    const int s = tid & 127, eg0 = tid >> 7;
#pragma unroll
    for (int it = 0; it < 4; ++it) r[it] = *(const u32x4*)(src + (size_t)s * 1024 + (eg0 + 4 * it) * 8);
}
__device__ __forceinline__ void st_tr(LAS bf16_t* dst, const u32x4 (&r)[4], int tid) {
    const int s = tid & 127, eg0 = tid >> 7;
#pragma unroll
    for (int it = 0; it < 4; ++it) { const int eg = eg0 + 4 * it; const unsigned vv[4] = {r[it].x, r[it].y, r[it].z, r[it].w};
#pragma unroll
        for (int j = 0; j < 4; ++j) { const int r0 = (eg * 8 + 2 * j) * TS + s; dst[r0] = (bf16_t)(vv[j] & 0xffffu); dst[r0 + TS] = (bf16_t)(vv[j] >> 16); } }
}

__device__ void phase_r3(const Params& p, LAS unsigned char* lds) {
    const int tid = threadIdx.x, wid = __builtin_amdgcn_readfirstlane(tid >> 6), lane = tid & 63, wr = wid >> 2, wc = wid & 3, fr = lane & 15, fq = lane >> 4;
    LAS bf16_t* Qs = (LAS bf16_t*)lds; LAS bf16_t* Ks = Qs + 128 * TS; LAS bf16_t* VT = Ks + 128 * TS; LAS bf16_t* Ss = VT + 128 * TS; LAS float* red = (LAS float*)(Ss + 128 * TS);
    const bf16_t* Qg = (const bf16_t*)(p.ws + WS_Q); const bf16_t* Kg = (const bf16_t*)(p.ws + WS_K); const bf16_t* Vg = (const bf16_t*)(p.ws + WS_V);
    const bf16_t* SG = (const bf16_t*)(p.ws + WS_SG); const bf16_t* ST = (const bf16_t*)(p.ws + WS_ST); bf16_t* BR0 = (bf16_t*)(p.ws + WS_BR);
    const int G = gridDim.x;
    u32x4 rq[4], rk[4];
    { const int unit = blockIdx.x;
      if (unit < 2048) { const int bh = unit >> 7, n = unit & 127, b = bh >> 3, h = bh & 7; const size_t rowbase = (size_t)b * SEQ + (size_t)n * 128;
        ld_nat(rq, Qg + rowbase * 1024 + h * 128, 1024, tid); ld_nat(rk, Kg + rowbase * 1024 + h * 128, 1024, tid); } }
    for (int unit = blockIdx.x; unit < 2048; unit += G) {
        const int bh = unit >> 7, n = unit & 127, b = bh >> 3, h = bh & 7;
        const float lgf = ((const float*)(p.ws + WS_LG))[h], lgb = ((const float*)(p.ws + WS_LG))[8 + h];
        const size_t rowbase = (size_t)b * SEQ + (size_t)n * 128;
        u32x4 rv[4], rs[4], rb[4];
        ld_tr(rv, Vg + rowbase * 1024 + h * 128, tid); ld_nat(rs, ST + ((size_t)((0 * 16 + bh) * 128 + n)) * 16384, 128, tid);
        ld_nat(rb, ST + ((size_t)((1 * 16 + bh) * 128 + n)) * 16384, 128, tid);
        u32x2 sg[4][2];
#pragma unroll
        for (int nn = 0; nn < 2; ++nn) { const int e0 = 32 * wc + 16 * nn + 4 * fq;
#pragma unroll
            for (int m = 0; m < 4; ++m) sg[m][nn] = *(const u32x2*)(SG + (rowbase + 64 * wr + 16 * m + fr) * 1024 + h * 128 + e0); }
        __builtin_amdgcn_sched_barrier(0);
        __syncthreads();
        st_nat(Qs, rq, tid); st_nat(Ks, rk, tid); st_nat(Ss, rs, tid); st_tr(VT, rv, tid);
        __builtin_amdgcn_sched_barrier(0);
        __syncthreads();
        f32x4 accP[4][2], acc1[4][2], acc2[4][2];
        zero_acc(accP); mm128(accP, Qs, Ks, wr, wc, fr, fq);
        float rowf[4], rowb[4], colf[2][4], colb[2][4];
#pragma unroll
        for (int m = 0; m < 4; ++m) { const float tf = (float)(64 * wr + 16 * m + fr); rowf[m] = __builtin_amdgcn_exp2f(tf * lgf); rowb[m] = __builtin_amdgcn_exp2f(-tf * lgb); }
#pragma unroll
        for (int nn = 0; nn < 2; ++nn)
#pragma unroll
            for (int j = 0; j < 4; ++j) { const float sf = (float)(32 * wc + 16 * nn + 4 * fq + j); colf[nn][j] = __builtin_amdgcn_exp2f(-sf * lgf); colb[nn][j] = __builtin_amdgcn_exp2f(sf * lgb); }
#pragma unroll
        for (int m = 0; m < 4; ++m)
#pragma unroll
            for (int nn = 0; nn < 2; ++nn)
#pragma unroll
                for (int j = 0; j < 4; ++j) { const int t = 64 * wr + 16 * m + fr, s = 32 * wc + 16 * nn + 4 * fq + j;
                    accP[m][nn][j] *= (s <= t) ? rowf[m] * colf[nn][j] : rowb[m] * colb[nn][j]; }
        zero_acc(acc1); mm128(acc1, Qs, Ss, wr, wc, fr, fq);
#pragma unroll
        for (int m = 0; m < 4; ++m)
#pragma unroll
            for (int nn = 0; nn < 2; ++nn) acc1[m][nn] *= rowf[m];
        __syncthreads();
#pragma unroll
        for (int m = 0; m < 4; ++m)
#pragma unroll
            for (int nn = 0; nn < 2; ++nn) { const int t = 64 * wr + 16 * m + fr, s = 32 * wc + 16 * nn + 4 * fq;
                u32x2 w; w.x = cvt_pk_bf16(accP[m][nn][0], accP[m][nn][1]); w.y = cvt_pk_bf16(accP[m][nn][2], accP[m][nn][3]);
                *(LAS u32x2*)(Ks + t * TS + s) = w; }
        st_nat(Ss, rb, tid);
        __builtin_amdgcn_sched_barrier(0);
        { const int nu = unit + G;
          if (nu < 2048) { const int bh2 = nu >> 7, n2 = nu & 127, b2 = bh2 >> 3, h2 = bh2 & 7; const size_t rowbase2 = (size_t)b2 * SEQ + (size_t)n2 * 128;
            ld_nat(rq, Qg + rowbase2 * 1024 + h2 * 128, 1024, tid); ld_nat(rk, Kg + rowbase2 * 1024 + h2 * 128, 1024, tid); } }
        __builtin_amdgcn_sched_barrier(0);
        __syncthreads();
        zero_acc(acc2); mm128(acc2, Qs, Ss, wr, wc, fr, fq);
        { const float g127 = __builtin_amdgcn_exp2f(127.0f * lgb);
#pragma unroll
          for (int m = 0; m < 4; ++m) { const float sc = g127 * rowb[m];
#pragma unroll
            for (int nn = 0; nn < 2; ++nn) acc1[m][nn] += acc2[m][nn] * sc; } }
        mm128(acc1, Ks, VT, wr, wc, fr, fq);
#pragma unroll
        for (int m = 0; m < 4; ++m) { float ss = 0.f;
#pragma unroll
            for (int nn = 0; nn < 2; ++nn) ss += (acc1[m][nn][0] * acc1[m][nn][0] + acc1[m][nn][1] * acc1[m][nn][1]) + (acc1[m][nn][2] * acc1[m][nn][2] + acc1[m][nn][3] * acc1[m][nn][3]);
            ss += __shfl_xor(ss, 16); ss += __shfl_xor(ss, 32);
            if (fq == 0) red[(64 * wr + 16 * m + fr) * 4 + wc] = ss; }
        __syncthreads();
#pragma unroll
        for (int m = 0; m < 4; ++m) { const int t = 64 * wr + 16 * m + fr; const f32x4 r4 = *(const LAS f32x4*)(red + t * 4);
            const float rstd = __builtin_amdgcn_rsqf(((r4[0] + r4[1]) + (r4[2] + r4[3])) * (1.0f / 128.0f) + 1e-6f);
#pragma unroll
            for (int nn = 0; nn < 2; ++nn) { const int e0 = 32 * wc + 16 * nn + 4 * fq; const f32x4 gg = *(const f32x4*)(p.gn_gain + h * 128 + e0);
                u32x2 w; w.x = cvt_pk_bf16(acc1[m][nn][0] * rstd * gg[0] * bf_lo(sg[m][nn].x), acc1[m][nn][1] * rstd * gg[1] * bf_hi(sg[m][nn].x));
                w.y = cvt_pk_bf16(acc1[m][nn][2] * rstd * gg[2] * bf_lo(sg[m][nn].y), acc1[m][nn][3] * rstd * gg[3] * bf_hi(sg[m][nn].y));
                *(u32x2*)(BR0 + (rowbase + t) * 1024 + h * 128 + e0) = w; } }
    }
}

__device__ void phase_final(const Params& p) {
    const int tid = threadIdx.x, lane = tid & 63, wv = tid >> 6; const float* SSQ = (const float*)(p.ws + WS_SSQ);
    f32x4 g[8];
#pragma unroll
    for (int i = 0; i < 8; ++i) g[i] = *(const f32x4*)(p.final_gain + i * 256 + lane * 4);
    for (int row = (blockIdx.x * 8 + wv) * 2; row < T_TOK; row += gridDim.x * 16) {
        float ss[2]; f32x4 y[2][8];
#pragma unroll
        for (int r = 0; r < 2; ++r) { ss[r] = lane < 32 ? SSQ[(size_t)(row + r) * 32 + lane] : 0.f;
#pragma unroll
            for (int i = 0; i < 8; ++i) y[r][i] = *(const f32x4*)(p.out + (size_t)(row + r) * DM + i * 256 + lane * 4); }
#pragma unroll
        for (int r = 0; r < 2; ++r) {
#pragma unroll
            for (int o = 32; o >= 1; o >>= 1) ss[r] += __shfl_xor(ss[r], o);
            const float rstd = rsqrtf(ss[r] * (1.0f / 2048.0f) + 1e-6f);
#pragma unroll
            for (int i = 0; i < 8; ++i) *(f32x4*)(p.out + (size_t)(row + r) * DM + i * 256 + lane * 4) = y[r][i] * rstd * g[i]; }
    }
}

__device__ __forceinline__ void grid_barrier(cg::grid_group& grid) {
    asm volatile("s_waitcnt vmcnt(0) lgkmcnt(0)" ::: "memory");
    grid.sync();
    __builtin_amdgcn_fence(__ATOMIC_ACQUIRE, "agent");
    asm volatile("s_waitcnt vmcnt(0)" ::: "memory");
}

__global__ void __launch_bounds__(512, 2) fwd_megakernel(Params p) {
    extern __shared__ __attribute__((aligned(16))) unsigned char lds_raw[];
    LAS unsigned char* lds = (LAS unsigned char*)lds_raw;
    cg::grid_group grid = cg::this_grid();
    unsigned char* ws = p.ws;
    const int G = gridDim.x, c = blockIdx.x;

#ifndef PHM
#define PHM 255
#endif
    if (PHM & 1) phase_prologue(p, lds);
    grid_barrier(grid);
    if (PHM & 2) {
        pg8::Gemm g{(const bf16_t*)(ws + WS_H), (const bf16_t*)(ws + WS_WIN), T_TOK, NCOL, 2048, 0, 0};
        pg8::Order S; S.init(T_TOK, NCOL, G, c, 0);
        Epi1 E{(bf16_t*)(ws + WS_Q), (bf16_t*)(ws + WS_K), (bf16_t*)(ws + WS_V), (bf16_t*)(ws + WS_SG), (bf16_t*)(ws + WS_UW), (bf16_t*)(ws + WS_GATE), (const float*)(ws + WS_COS), (const float*)(ws + WS_SIN)};
        pg8::gemm_phase<Epi1>(lds, g, S, E);
    }
    grid_barrier(grid);
    if (PHM & 4) phase_r1(p, lds);
    if (PHM & 4) phase_conv(p);
    grid_barrier(grid);
    if (PHM & 8) phase_scan(p);
    grid_barrier(grid);
    if (PHM & 16) phase_r3(p, lds);
    grid_barrier(grid);
    if (PHM & 32) {
        pg8::Gemm g{(const bf16_t*)(ws + WS_BR), (const bf16_t*)(ws + WS_WB), T_TOK, 2048, 1024, (size_t)T_TOK * 1024 * 2, (size_t)2048 * 1024 * 2};
        pg8::Order S; S.init(T_TOK, 2048, G, c, 1);
        Epi2 E{(const bf16_t*)(ws + WS_GATE), (bf16_t*)(ws + WS_MERGED)};
        pg8::gemm_phase<Epi2>(lds, g, S, E);
    }
    grid_barrier(grid);
    if (PHM & 64) {
        pg8::Gemm g{(const bf16_t*)(ws + WS_MERGED), (const bf16_t*)(ws + WS_WO), T_TOK, 2048, 2048, 0, 0};
        pg8::Order S; S.init(T_TOK, 2048, G, c, 0);
        Epi3 E{p.x, p.out, (float*)(ws + WS_SSQ)};
        pg8::gemm_phase<Epi3>(lds, g, S, E);
    }
    grid_barrier(grid);
    if (PHM & 128) phase_final(p);
}

extern "C" void kernel_launch(void* const* d_in, const int* in_sizes, int n_in, void* d_out, int out_size, void* d_ws, size_t ws_size, hipStream_t stream) {
    static int grid_blocks = 0;
    if (!grid_blocks) {
        if (n_in != 10 || out_size != T_TOK * DM || ws_size < WS_END) { fprintf(stderr, "kernel_launch: unexpected shapes (n_in %d out %d ws %zu)\n", n_in, out_size, ws_size); grid_blocks = -1; return; }
        int dev = 0, cus = 0, per_cu = 0;
        hipGetDevice(&dev);
        hipDeviceGetAttribute(&cus, hipDeviceAttributeMultiprocessorCount, dev);
        if (hipFuncSetAttribute((const void*)fwd_megakernel, hipFuncAttributeMaxDynamicSharedMemorySize, LDS_BYTES) != hipSuccess) { fprintf(stderr, "kernel_launch: hipFuncSetAttribute failed\n"); grid_blocks = -1; return; }
        hipOccupancyMaxActiveBlocksPerMultiprocessor(&per_cu, (const void*)fwd_megakernel, 512, LDS_BYTES);
        if (per_cu < 1) { fprintf(stderr, "kernel_launch: occupancy query says %d blocks per CU\n", per_cu); per_cu = 1; }
        grid_blocks = cus * per_cu;
    }
    if (grid_blocks < 0) return;
    Params p{};
    p.x = (const float*)d_in[0]; p.norm_gain = (const float*)d_in[1]; p.w_in = (const float*)d_in[2]; p.lg_f = (const float*)d_in[3]; p.lg_b = (const float*)d_in[4];
    p.gn_gain = (const float*)d_in[5]; p.conv_w = (const float*)d_in[6]; p.w_branch = (const float*)d_in[7]; p.w_out = (const float*)d_in[8]; p.final_gain = (const float*)d_in[9];
    p.out = (float*)d_out; p.ws = (unsigned char*)d_ws;
    void* args[] = {&p};
    hipError_t e = hipLaunchCooperativeKernel((const void*)fwd_megakernel, dim3(grid_blocks), dim3(512), args, LDS_BYTES, stream);
    if (e != hipSuccess) fprintf(stderr, "cooperative launch failed: %s (grid %d)\n", hipGetErrorString(e), grid_blocks);
}
```

```cpp
#include <hip/hip_runtime.h>
#include <hip/hip_cooperative_groups.h>
#include <cstdio>
namespace cg = cooperative_groups;

#define LAS __attribute__((address_space(3)))
typedef unsigned short bf16_t;
typedef short bf16x8 __attribute__((ext_vector_type(8)));
typedef float f32x4 __attribute__((ext_vector_type(4)));
typedef unsigned u32x4 __attribute__((ext_vector_type(4)));
typedef unsigned u32x2 __attribute__((ext_vector_type(2)));

constexpr int T_TOK = 32768, DM = 2048, SEQ = 16384, NCOL = 12288;
constexpr size_t MiB = 1ull << 20;
constexpr size_t WS_H = 0, WS_KV = 0, WS_WIN = 128 * MiB, WS_WB = 176 * MiB, WS_WO = 184 * MiB, WS_COS = 192 * MiB, WS_SIN = 196 * MiB,
                 WS_Q = 200 * MiB, WS_K = 264 * MiB, WS_MERGED = 200 * MiB, WS_V = 328 * MiB, WS_SG = 392 * MiB, WS_UW = 456 * MiB, WS_ST = 456 * MiB,
                 WS_GATE = 584 * MiB, WS_BR = 840 * MiB, WS_SSQ = 968 * MiB, WS_LG = 972 * MiB, WS_BAR = 972 * MiB + 65536, WS_END = 973 * MiB;
constexpr int LDS_BYTES = 147456;
constexpr int TS = 136;

struct Params {
    const float* x; const float* norm_gain; const float* w_in; const float* lg_f; const float* lg_b; const float* gn_gain;
    const float* conv_w; const float* w_branch; const float* w_out; const float* final_gain; float* out; unsigned char* ws;
};

typedef __bf16 bf16x2_t __attribute__((ext_vector_type(2)));
typedef float f32x2_t __attribute__((ext_vector_type(2)));
__device__ __forceinline__ unsigned cvt_pk_bf16(float lo, float hi) { f32x2_t v = {lo, hi}; bf16x2_t b = __builtin_convertvector(v, bf16x2_t); return __builtin_bit_cast(unsigned, b); }
__device__ __forceinline__ bf16_t f2bf(float f) { unsigned u = __float_as_uint(f); u += 0x7FFFu + ((u >> 16) & 1u); return (bf16_t)(u >> 16); }
__device__ __forceinline__ float bf_lo(unsigned w) { return __uint_as_float(w << 16); }
__device__ __forceinline__ float bf_hi(unsigned w) { return __uint_as_float(w & 0xffff0000u); }
__device__ __forceinline__ float sigmoidf_(float x) { return __builtin_amdgcn_rcpf(1.0f + __expf(-x)); }
__device__ __forceinline__ float log2_sigmoid(float x) { return -log1pf(expf(-x)) * 1.4426950408889634f; }

namespace pg8 {
constexpr int BM = 256, BK = 64, HALF = 128, HTB = HALF * BK * 2, STAGE_BYTES = 8 * HTB, NXCD = 8, WGM = 8;
__host__ __device__ __forceinline__ int lds_byte(int r, int c) { const int st = (r >> 4) * 2 + (c >> 5), rr = r & 15, cc = c & 31, ob = rr * 64 + cc * 2; return st * 1024 + (ob ^ (((ob >> 9) & 1) << 5)); }
__host__ __device__ __forceinline__ void stage_rc(int b, int& R, int& C) { const int st = b / 1024, sb = b % 1024, swz = sb ^ (((sb >> 9) & 1) << 5); R = (st >> 1) * 16 + swz / 64; C = (st & 1) * 32 + (swz % 64) / 2; }
__host__ __device__ __forceinline__ int perm32(int rho) { const int n = rho >> 4, i = rho & 15; return 8 * (i >> 2) + 4 * n + (i & 3); }

struct Unit { int pm, pn, z; };
struct Gemm { const bf16_t* A; const bf16_t* Bt; int M, N, K; size_t zA, zB; };

struct Order {
    int nM, nN, nwg, G, c, zsh;
    __device__ void init(int M, int N, int G_, int c_, int zsh_) { nM = M / BM; nN = N / BM; nwg = nM * nN; G = G_; c = c_; zsh = zsh_; }
    __device__ bool next(int i, Unit& u) const {
        const int ti = i >> zsh; u.z = i & ((1 << zsh) - 1);
        const long L = (long)ti * G + c; if (L >= nwg) return false;
        int wgid = (int)L; { const int q = nwg / NXCD, r = nwg % NXCD, xcd = wgid % NXCD, off = wgid / NXCD; wgid = (xcd < r ? xcd * (q + 1) : r * (q + 1) + (xcd - r) * q) + off; }
        const int nig = WGM * nN, gid = wgid / nig, fm = gid * WGM, gsz = (nM - fm) < WGM ? (nM - fm) : WGM;
        u.pm = fm + ((wgid % nig) % gsz); u.pn = (wgid % nig) / gsz; return true;
    }
};

template <class Epi>
__device__ __forceinline__ void gemm_phase(LAS unsigned char* lds, const Gemm g, const Order& S, const Epi& E) {
    const int tid = threadIdx.x, wid = __builtin_amdgcn_readfirstlane(tid >> 6), lane = tid & 63, wr = wid >> 2, wc = wid & 3, fr = lane & 15, fq = lane >> 4;
    const int K = g.K, nt = K / BK;
    unsigned voffA[2], voffB[2];
#pragma unroll
    for (int i = 0; i < 2; ++i) { int R, C; stage_rc(tid * 16 + i * 8192, R, C); const int Rb = Epi::PERM ? ((R & ~31) + perm32(R & 31)) : R;
        voffA[i] = (unsigned)(R * K + C) * 2u; voffB[i] = (unsigned)(Rb * K + C) * 2u; }
    const size_t kstep = (size_t)(BK * 2);
    const size_t hstep = (size_t)HALF * K * 2;
    const size_t tstep = 2 * hstep;
    const unsigned ldsw = (unsigned)wid * 1024u;
    const int aoff = lds_byte(wr * 64 + fr, fq * 8), boff = lds_byte(wc * 32 + fr, fq * 8);
#define PG8_SA(b, h) (((b) * 2 + (h)) * HTB)
#define PG8_SB(b, h) ((4 + (b) * 2 + (h)) * HTB)
#define PG8_STAGE(bufoff, gbase, voff) do { _Pragma("unroll") for (int _i = 0; _i < 2; ++_i) \
        __builtin_amdgcn_global_load_lds((const unsigned*)((const char*)(gbase) + (voff)[_i]), (LAS unsigned*)(lds + (bufoff) + ldsw + _i * 8192), 16, 0, 0); } while (0)
#define PG8_LDA(dst, b, h) do { _Pragma("unroll") for (int m = 0; m < 4; ++m) _Pragma("unroll") for (int k = 0; k < 2; ++k) dst[m][k] = *(const LAS bf16x8*)(lds + PG8_SA(b, h) + aoff + m * 2048 + k * 1024); } while (0)
#define PG8_LDB(dst, b, h) do { _Pragma("unroll") for (int n = 0; n < 2; ++n) _Pragma("unroll") for (int k = 0; k < 2; ++k) dst[n][k] = *(const LAS bf16x8*)(lds + PG8_SB(b, h) + boff + n * 2048 + k * 1024); } while (0)
#define PG8_MMA(ai, bj, At, Bt) do { __builtin_amdgcn_s_setprio(1); _Pragma("unroll") for (int m = 0; m < 4; ++m) _Pragma("unroll") for (int n = 0; n < 2; ++n) _Pragma("unroll") for (int k = 0; k < 2; ++k) \
        acc[ai][bj][m][n] = __builtin_amdgcn_mfma_f32_16x16x32_bf16(Bt[n][k], At[m][k], acc[ai][bj][m][n], 0, 0, 0); __builtin_amdgcn_s_setprio(0); } while (0)
#define PG8_WAIT_V(n) asm volatile("s_waitcnt vmcnt(" #n ")" ::: "memory")
#define PG8_WAIT_L(n) asm volatile("s_waitcnt lgkmcnt(" #n ")" ::: "memory")
#define PG8_BAR __builtin_amdgcn_s_barrier()
#define PG8_SCHED __builtin_amdgcn_sched_barrier(0)
    Unit cur, nxt; int ui = 0;
    if (!S.next(0, cur)) return;
    f32x4 acc[2][2][4][2];
#pragma unroll
    for (int a = 0; a < 2; ++a)
#pragma unroll
        for (int b = 0; b < 2; ++b)
#pragma unroll
            for (int m = 0; m < 4; ++m)
#pragma unroll
                for (int n = 0; n < 2; ++n) acc[a][b][m][n] = (f32x4){0.f, 0.f, 0.f, 0.f};
    bf16x8 At[4][2], B0[2][2], B1[2][2];
    const char* cA = (const char*)g.A + (size_t)cur.pm * tstep + (size_t)cur.z * g.zA; const char* cB = (const char*)g.Bt + (size_t)cur.pn * tstep + (size_t)cur.z * g.zB;
    PG8_STAGE(PG8_SB(0, 0), cB, voffB); PG8_STAGE(PG8_SA(0, 0), cA, voffA); PG8_STAGE(PG8_SB(0, 1), cB + hstep, voffB); PG8_STAGE(PG8_SA(0, 1), cA + hstep, voffA);
    if (wr == 1) PG8_BAR;
    PG8_WAIT_V(4); PG8_BAR;
    PG8_STAGE(PG8_SB(1, 0), cB + kstep, voffB); PG8_STAGE(PG8_SA(1, 0), cA + kstep, voffA); PG8_STAGE(PG8_SB(1, 1), cB + hstep + kstep, voffB);
    PG8_WAIT_V(6); PG8_BAR;
    for (;;) {
        const bool has_next = S.next(ui + 1, nxt);
        const char* nA = has_next ? (const char*)g.A + (size_t)nxt.pm * tstep + (size_t)nxt.z * g.zA : cA;
        const char* nB = has_next ? (const char*)g.Bt + (size_t)nxt.pn * tstep + (size_t)nxt.z * g.zB : cB;
        for (int t = 0; t < nt; t += 2) {
            const bool last = (t == nt - 2);
            const char* a1 = cA + (size_t)(t + 1) * kstep;
            const char* a2 = last ? nA : cA + (size_t)(t + 2) * kstep; const char* b2 = last ? nB : cB + (size_t)(t + 2) * kstep;
            const char* a3 = a2 + kstep; const char* b3 = b2 + kstep;
            PG8_LDB(B0, 0, 0); PG8_SCHED; PG8_LDA(At, 0, 0); PG8_STAGE(PG8_SA(1, 1), a1 + hstep, voffA);
            PG8_WAIT_L(8); PG8_BAR; PG8_WAIT_L(0); PG8_MMA(0, 0, At, B0); PG8_BAR; PG8_SCHED;
            PG8_LDB(B1, 0, 1); PG8_STAGE(PG8_SB(0, 0), b2, voffB);
            PG8_BAR; PG8_WAIT_L(0); PG8_MMA(0, 1, At, B1); PG8_BAR;
            PG8_LDA(At, 0, 1); PG8_STAGE(PG8_SA(0, 0), a2, voffA);
            PG8_BAR; PG8_WAIT_L(0); PG8_MMA(1, 0, At, B0); PG8_BAR; PG8_SCHED;
            PG8_STAGE(PG8_SB(0, 1), b2 + hstep, voffB);
            PG8_WAIT_V(6); PG8_BAR; PG8_MMA(1, 1, At, B1); PG8_BAR;
            PG8_LDB(B0, 1, 0); PG8_SCHED; PG8_LDA(At, 1, 0); PG8_STAGE(PG8_SA(0, 1), a2 + hstep, voffA);
            PG8_WAIT_L(8); PG8_BAR; PG8_WAIT_L(0); PG8_MMA(0, 0, At, B0); PG8_BAR; PG8_SCHED;
            PG8_LDB(B1, 1, 1); PG8_STAGE(PG8_SB(1, 0), b3, voffB);
            PG8_BAR; PG8_WAIT_L(0); PG8_MMA(0, 1, At, B1); PG8_BAR;
            PG8_LDA(At, 1, 1); PG8_STAGE(PG8_SA(1, 0), a3, voffA);
            PG8_BAR; PG8_WAIT_L(0); PG8_MMA(1, 0, At, B0); PG8_BAR; PG8_SCHED;
            PG8_STAGE(PG8_SB(1, 1), b3 + hstep, voffB);
            PG8_WAIT_V(6); PG8_BAR; PG8_MMA(1, 1, At, B1); PG8_BAR;
        }
        E(acc, cur, wr, wc, fr, fq);
        if (!has_next) break;
#pragma unroll
        for (int a = 0; a < 2; ++a)
#pragma unroll
            for (int b = 0; b < 2; ++b)
#pragma unroll
                for (int m = 0; m < 4; ++m)
#pragma unroll
                    for (int n = 0; n < 2; ++n) acc[a][b][m][n] = (f32x4){0.f, 0.f, 0.f, 0.f};
        cur = nxt; cA = nA; cB = nB; ++ui;
    }
    PG8_WAIT_V(0);
    if (wr == 0) PG8_BAR;
    PG8_BAR;
#undef PG8_SA
#undef PG8_SB
#undef PG8_STAGE
#undef PG8_LDA
#undef PG8_LDB
#undef PG8_MMA
#undef PG8_WAIT_V
#undef PG8_WAIT_L
#undef PG8_BAR
#undef PG8_SCHED
}
}

struct Epi1 {
    static constexpr bool PERM = true;
    bf16_t *Q, *K, *V, *SG, *UW, *GATE; const float *COS, *SIN;
    __device__ __forceinline__ void operator()(const f32x4 (&acc)[2][2][4][2], const pg8::Unit& u, int wr, int wc, int fr, int fq) const {
        const int row0 = u.pm * 256 + wr * 64 + fr, lc = wc * 32 + 8 * fq, pn = u.pn;
        if (pn < 8) {
            bf16_t* base = (pn < 4 ? Q : K) + (pn & 3) * 256 + lc;
            const int i0 = lc >> 1;
#pragma unroll
            for (int ai = 0; ai < 2; ++ai) {
                f32x4 cs[4], sn[4];
#pragma unroll
                for (int m = 0; m < 4; ++m) { const int pos = (row0 + ai * 128 + m * 16) & (SEQ - 1);
                    cs[m] = *(const f32x4*)(COS + pos * 64 + i0); sn[m] = *(const f32x4*)(SIN + pos * 64 + i0); }
#pragma unroll
                for (int m = 0; m < 4; ++m) {
                    const int row = row0 + ai * 128 + m * 16;
#pragma unroll
                    for (int bj = 0; bj < 2; ++bj) {
                        const f32x4 v0 = acc[ai][bj][m][0], v1 = acc[ai][bj][m][1]; u32x4 w;
                        w.x = cvt_pk_bf16(v0[0] * cs[m][0] - v0[1] * sn[m][0], v0[1] * cs[m][0] + v0[0] * sn[m][0]);
                        w.y = cvt_pk_bf16(v0[2] * cs[m][1] - v0[3] * sn[m][1], v0[3] * cs[m][1] + v0[2] * sn[m][1]);
                        w.z = cvt_pk_bf16(v1[0] * cs[m][2] - v1[1] * sn[m][2], v1[1] * cs[m][2] + v1[0] * sn[m][2]);
                        w.w = cvt_pk_bf16(v1[2] * cs[m][3] - v1[3] * sn[m][3], v1[3] * cs[m][3] + v1[2] * sn[m][3]);
                        *(u32x4*)(base + (size_t)row * 1024 + bj * 128) = w; }
                }
            }
        } else if (pn < 16) {
            const bool act = pn >= 12;
            bf16_t* base = (act ? SG : V) + (pn & 3) * 256 + lc;
#pragma unroll
            for (int ai = 0; ai < 2; ++ai)
#pragma unroll
                for (int m = 0; m < 4; ++m) {
                    const int row = row0 + ai * 128 + m * 16;
#pragma unroll
                    for (int bj = 0; bj < 2; ++bj) {
                        f32x4 v0 = acc[ai][bj][m][0], v1 = acc[ai][bj][m][1];
                        if (act) {
#pragma unroll
                            for (int j = 0; j < 4; ++j) { v0[j] = v0[j] * sigmoidf_(v0[j]); v1[j] = v1[j] * sigmoidf_(v1[j]); } }
                        u32x4 w; w.x = cvt_pk_bf16(v0[0], v0[1]); w.y = cvt_pk_bf16(v0[2], v0[3]); w.z = cvt_pk_bf16(v1[0], v1[1]); w.w = cvt_pk_bf16(v1[2], v1[3]);
                        *(u32x4*)(base + (size_t)row * 1024 + bj * 128) = w; }
                }
        } else if (pn < 32) {
            const int ch0 = 64 * (pn - 16) + 16 * wc + 4 * fq;
#pragma unroll
            for (int ai = 0; ai < 2; ++ai)
#pragma unroll
                for (int m = 0; m < 4; ++m) {
                    const int row = row0 + ai * 128 + m * 16;
                    const f32x4 cc = acc[ai][0][m][0], cx = acc[ai][0][m][1], cb = acc[ai][1][m][0], g = acc[ai][1][m][1];
                    u32x4 w;
                    w.x = cvt_pk_bf16(cc[0] * cx[0], cb[0] * g[0] * sigmoidf_(g[0]));
                    w.y = cvt_pk_bf16(cc[1] * cx[1], cb[1] * g[1] * sigmoidf_(g[1]));
                    w.z = cvt_pk_bf16(cc[2] * cx[2], cb[2] * g[2] * sigmoidf_(g[2]));
                    w.w = cvt_pk_bf16(cc[3] * cx[3], cb[3] * g[3] * sigmoidf_(g[3]));
                    *(u32x4*)(UW + ((size_t)row * 1024 + ch0) * 2) = w;
                }
        } else {
            bf16_t* base = GATE + (pn - 32) * 256 + lc;
#pragma unroll
            for (int ai = 0; ai < 2; ++ai)
#pragma unroll
                for (int m = 0; m < 4; ++m) {
                    const int row = row0 + ai * 128 + m * 16;
#pragma unroll
                    for (int bj = 0; bj < 2; ++bj) {
                        const f32x4 v0 = acc[ai][bj][m][0], v1 = acc[ai][bj][m][1];
                        u32x4 w; w.x = cvt_pk_bf16(sigmoidf_(v0[0]), sigmoidf_(v0[1])); w.y = cvt_pk_bf16(sigmoidf_(v0[2]), sigmoidf_(v0[3]));
                        w.z = cvt_pk_bf16(sigmoidf_(v1[0]), sigmoidf_(v1[1])); w.w = cvt_pk_bf16(sigmoidf_(v1[2]), sigmoidf_(v1[3]));
                        *(u32x4*)(base + (size_t)row * 4096 + bj * 128) = w; }
                }
        }
    }
};

struct Epi2 {
    static constexpr bool PERM = true;
    const bf16_t* GATE; bf16_t* MERGED;
    __device__ __forceinline__ void operator()(const f32x4 (&acc)[2][2][4][2], const pg8::Unit& u, int wr, int wc, int fr, int fq) const {
        const int row0 = u.pm * 256 + wr * 64 + fr, col = u.pn * 256 + wc * 32 + 8 * fq;
#pragma unroll
        for (int ai = 0; ai < 2; ++ai) {
            u32x4 gw[4][2], pw[4][2];
#pragma unroll
            for (int m = 0; m < 4; ++m)
#pragma unroll
                for (int bj = 0; bj < 2; ++bj) { const int row = row0 + ai * 128 + m * 16;
                    gw[m][bj] = *(const u32x4*)(GATE + (size_t)row * 4096 + u.z * 2048 + col + bj * 128);
                    pw[m][bj] = u.z ? *(const u32x4*)(MERGED + (size_t)row * 2048 + col + bj * 128) : (u32x4){0u, 0u, 0u, 0u}; }
#pragma unroll
            for (int m = 0; m < 4; ++m)
#pragma unroll
                for (int bj = 0; bj < 2; ++bj) { const int row = row0 + ai * 128 + m * 16;
                    const u32x4 g = gw[m][bj], pv = pw[m][bj]; const f32x4 v0 = acc[ai][bj][m][0], v1 = acc[ai][bj][m][1];
                    u32x4 w;
                    w.x = cvt_pk_bf16(bf_lo(g.x) * v0[0] + bf_lo(pv.x), bf_hi(g.x) * v0[1] + bf_hi(pv.x));
                    w.y = cvt_pk_bf16(bf_lo(g.y) * v0[2] + bf_lo(pv.y), bf_hi(g.y) * v0[3] + bf_hi(pv.y));
                    w.z = cvt_pk_bf16(bf_lo(g.z) * v1[0] + bf_lo(pv.z), bf_hi(g.z) * v1[1] + bf_hi(pv.z));
                    w.w = cvt_pk_bf16(bf_lo(g.w) * v1[2] + bf_lo(pv.w), bf_hi(g.w) * v1[3] + bf_hi(pv.w));
                    *(u32x4*)(MERGED + (size_t)row * 2048 + col + bj * 128) = w; }
        }
    }
};

struct Epi3 {
    static constexpr bool PERM = false;
    const float* X; float* OUT; float* SSQ;
    __device__ __forceinline__ void operator()(const f32x4 (&acc)[2][2][4][2], const pg8::Unit& u, int wr, int wc, int fr, int fq) const {
        const int row0 = u.pm * 256 + wr * 64 + fr, col0 = u.pn * 256 + wc * 32 + 4 * fq;
#pragma unroll
        for (int ai = 0; ai < 2; ++ai) {
            f32x4 xv[4][2][2];
#pragma unroll
            for (int m = 0; m < 4; ++m)
#pragma unroll
                for (int bj = 0; bj < 2; ++bj)
#pragma unroll
                    for (int n = 0; n < 2; ++n) xv[m][bj][n] = *(const f32x4*)(X + (size_t)(row0 + ai * 128 + m * 16) * 2048 + col0 + bj * 128 + n * 16);
#pragma unroll
            for (int m = 0; m < 4; ++m) {
                const int row = row0 + ai * 128 + m * 16; const size_t off = (size_t)row * 2048 + col0; float ss = 0.f;
#pragma unroll
                for (int bj = 0; bj < 2; ++bj)
#pragma unroll
                    for (int n = 0; n < 2; ++n) { const f32x4 y = xv[m][bj][n] + acc[ai][bj][m][n];
                        *(f32x4*)(OUT + off + bj * 128 + n * 16) = y; ss += (y[0] * y[0] + y[1] * y[1]) + (y[2] * y[2] + y[3] * y[3]); }
                ss += __shfl_xor(ss, 16); ss += __shfl_xor(ss, 32);
                if (fq == 0) SSQ[(size_t)row * 32 + u.pn * 4 + wc] = ss;
            }
        }
    }
};

__device__ __forceinline__ int win_src_col(int c, float& scale) {
    scale = 1.0f;
    if (c < 2048) { const int p = c & 127; if (c >= 1024) scale = 0.08838834764831845f; return (c & ~127) + (p >> 1) + 64 * (p & 1); }
    if (c < 4096 || c >= 8192) return c;
    const int l = (c - 4096) & 255, ct = (c - 4096) >> 8, bj = l >> 7, rem = l & 127, wc = rem >> 5, fq = (rem & 31) >> 3, j8 = rem & 7;
    const int ch = 64 * ct + 16 * wc + 4 * fq + (j8 & 3);
    const int qty = bj == 0 ? (j8 < 4 ? 1 : 2) : (j8 < 4 ? 0 : 3);
    return 4096 + qty * 1024 + ch;
}

__device__ void phase_prologue(const Params& p, LAS unsigned char* lds) {
    const int tid = threadIdx.x, G = gridDim.x;
    unsigned char* ws = p.ws;
    if (blockIdx.x == 0 && tid < 16) ((float*)(ws + WS_LG))[tid] = log2_sigmoid(tid < 8 ? p.lg_f[tid] : p.lg_b[tid - 8]);
    LAS float* tile = (LAS float*)lds;
    for (int tix = blockIdx.x; tix < 8192; tix += G) {
        const float* src; bf16_t* dst; int ld, Kd, n0, k0; bool isin = false;
        if (tix < 6144) { src = p.w_in; dst = (bf16_t*)(ws + WS_WIN); ld = NCOL; Kd = 2048; n0 = (tix >> 5) * 64; k0 = (tix & 31) * 64; isin = true; }
        else if (tix < 7168) { const int t = tix - 6144, z = t >> 9, tt = t & 511; src = p.w_branch + (size_t)z * 1024 * 2048; dst = (bf16_t*)(ws + WS_WB) + (size_t)z * 2048 * 1024; ld = 2048; Kd = 1024; n0 = (tt >> 4) * 64; k0 = (tt & 15) * 64; }
        else { const int t = tix - 7168; src = p.w_out; dst = (bf16_t*)(ws + WS_WO); ld = 2048; Kd = 2048; n0 = (t >> 5) * 64; k0 = (t & 31) * 64; }
        __syncthreads();
        { const int nn = tid & 63, kk0 = tid >> 6; float sc = 1.0f; const int scol = isin ? win_src_col(n0 + nn, sc) : (n0 + nn);
#pragma unroll
          for (int it = 0; it < 8; ++it) { const int kk = kk0 + 8 * it; tile[kk * 65 + nn] = src[(size_t)(k0 + kk) * ld + scol] * sc; } }
        __syncthreads();
        { const int nn = tid >> 3, kq = tid & 7; float v[8];
#pragma unroll
          for (int j = 0; j < 8; ++j) v[j] = tile[(kq * 8 + j) * 65 + nn];
          u32x4 w; w.x = cvt_pk_bf16(v[0], v[1]); w.y = cvt_pk_bf16(v[2], v[3]); w.z = cvt_pk_bf16(v[4], v[5]); w.w = cvt_pk_bf16(v[6], v[7]);
          *(u32x4*)(dst + (size_t)(n0 + nn) * Kd + k0 + kq * 8) = w; }
    }
    {
        float* COS = (float*)(ws + WS_COS); float* SIN = (float*)(ws + WS_SIN);
        for (int idx = blockIdx.x * 512 + tid; idx < SEQ * 64; idx += G * 512) {
            const int pos = idx >> 6, i = idx & 63;
            const float invf = (float)exp2(-(double)i * (13.287712379549449 / 64.0));
            const float angf = (float)pos * invf;
            const double a = (double)angf;
            const double n = rint(a * 0.15915494309189535);
            double r = fma(-n, 6.283185307179586, a); r = fma(-n, 2.4492935982947064e-16, r);
            const double qd = rint(r * 0.6366197723675814); const int q = (int)qd;
            double y = fma(-qd, 1.5707963267948966, r); y = fma(-qd, 6.123233995736766e-17, y);
            const double y2 = y * y;
            double sp = -2.5052108385441720e-08; sp = fma(sp, y2, 2.7557319223985893e-06); sp = fma(sp, y2, -1.9841269841269841e-04); sp = fma(sp, y2, 8.3333333333333332e-03); sp = fma(sp, y2, -1.6666666666666666e-01);
            const double sy = fma(y * y2, sp, y);
            double cp = 2.0876756987868099e-09; cp = fma(cp, y2, -2.7557319223985888e-07); cp = fma(cp, y2, 2.4801587301587302e-05); cp = fma(cp, y2, -1.3888888888888889e-03); cp = fma(cp, y2, 4.1666666666666664e-02); cp = fma(cp, y2, -0.5);
            const double cy = fma(y2, cp, 1.0);
            double s, c;
            switch (q & 3) { case 0: s = sy; c = cy; break; case 1: s = cy; c = -sy; break; case 2: s = -sy; c = -cy; break; default: s = -cy; c = sy; break; }
            COS[idx] = (float)c; SIN[idx] = (float)s;
        }
    }
    {
        bf16_t* H = (bf16_t*)(ws + WS_H); const int lane = tid & 63, wv = tid >> 6;
        f32x4 gn[8];
#pragma unroll
        for (int i = 0; i < 8; ++i) gn[i] = *(const f32x4*)(p.norm_gain + i * 256 + lane * 4);
        for (int row = (blockIdx.x * 8 + wv) * 2; row < T_TOK; row += G * 16) {
            f32x4 v[2][8]; float ss[2] = {0.f, 0.f};
#pragma unroll
            for (int r = 0; r < 2; ++r)
#pragma unroll
                for (int i = 0; i < 8; ++i) v[r][i] = *(const f32x4*)(p.x + (size_t)(row + r) * DM + i * 256 + lane * 4);
#pragma unroll
            for (int r = 0; r < 2; ++r) {
#pragma unroll
                for (int i = 0; i < 8; ++i) ss[r] += (v[r][i][0] * v[r][i][0] + v[r][i][1] * v[r][i][1]) + (v[r][i][2] * v[r][i][2] + v[r][i][3] * v[r][i][3]);
#pragma unroll
                for (int o = 32; o >= 1; o >>= 1) ss[r] += __shfl_xor(ss[r], o);
                const float rstd = rsqrtf(ss[r] * (1.0f / 2048.0f) + 1e-6f);
#pragma unroll
                for (int i = 0; i < 8; ++i) {
                    u32x2 w; w.x = cvt_pk_bf16(v[r][i][0] * rstd * gn[i][0], v[r][i][1] * rstd * gn[i][1]); w.y = cvt_pk_bf16(v[r][i][2] * rstd * gn[i][2], v[r][i][3] * rstd * gn[i][3]);
                    *(u32x2*)(H + (size_t)(row + r) * DM + i * 256 + lane * 4) = w; }
            }
        }
    }
}

__device__ __forceinline__ void mm128(f32x4 (&acc)[4][2], const LAS bf16_t* At, const LAS bf16_t* Bt, int wr, int wc, int fr, int fq) {
    __builtin_amdgcn_sched_barrier(0);
#pragma unroll 1
    for (int kb = 0; kb < 4; ++kb) {
        bf16x8 a[4], b[2];
#pragma unroll
        for (int m = 0; m < 4; ++m) a[m] = *(const LAS bf16x8*)(At + (64 * wr + 16 * m + fr) * TS + kb * 32 + fq * 8);
#pragma unroll
        for (int n = 0; n < 2; ++n) b[n] = *(const LAS bf16x8*)(Bt + (32 * wc + 16 * n + fr) * TS + kb * 32 + fq * 8);
#pragma unroll
        for (int m = 0; m < 4; ++m)
#pragma unroll
            for (int n = 0; n < 2; ++n) acc[m][n] = __builtin_amdgcn_mfma_f32_16x16x32_bf16(b[n], a[m], acc[m][n], 0, 0, 0);
    }
}
__device__ __forceinline__ void zero_acc(f32x4 (&acc)[4][2]) {
#pragma unroll
    for (int m = 0; m < 4; ++m)
#pragma unroll
        for (int n = 0; n < 2; ++n) acc[m][n] = (f32x4){0.f, 0.f, 0.f, 0.f};
}
__device__ __forceinline__ void stage_nat(LAS bf16_t* dst, const bf16_t* src, size_t ld, int tid) {
#pragma unroll
    for (int it = 0; it < 4; ++it) { const int idx = tid + 512 * it, row = idx >> 4, cg8 = idx & 15;
        const u32x4 v = *(const u32x4*)(src + (size_t)row * ld + cg8 * 8); *(LAS u32x4*)(dst + row * TS + cg8 * 8) = v; }
}

__device__ void phase_r1(const Params& p, LAS unsigned char* lds) {
    const int tid = threadIdx.x, wid = __builtin_amdgcn_readfirstlane(tid >> 6), lane = tid & 63, wr = wid >> 2, wc = wid & 3, fr = lane & 15, fq = lane >> 4;
    LAS bf16_t* VT = (LAS bf16_t*)lds; LAS bf16_t* KfT = VT + 128 * TS; LAS bf16_t* KbT = KfT + 128 * TS;
    const bf16_t* Kg = (const bf16_t*)(p.ws + WS_K); const bf16_t* Vg = (const bf16_t*)(p.ws + WS_V); bf16_t* KV = (bf16_t*)(p.ws + WS_KV);
    for (int unit = blockIdx.x; unit < 2048; unit += gridDim.x) {
        const int bh = unit >> 7, n = unit & 127, b = bh >> 3, h = bh & 7;
        const float lgf = ((const float*)(p.ws + WS_LG))[h], lgb = ((const float*)(p.ws + WS_LG))[8 + h];
        const size_t rowbase = (size_t)b * SEQ + (size_t)n * 128;
        __syncthreads();
        { const int s = tid & 127, eg0 = tid >> 7;
          const float wf = exp2f((float)(128 - s) * lgf), wb = exp2f((float)(s + 1) * lgb);
#pragma unroll
          for (int it = 0; it < 4; ++it) { const int eg = eg0 + 4 * it;
              const u32x4 kw = *(const u32x4*)(Kg + (rowbase + s) * 1024 + h * 128 + eg * 8);
              const u32x4 vw = *(const u32x4*)(Vg + (rowbase + s) * 1024 + h * 128 + eg * 8);
              const unsigned kk[4] = {kw.x, kw.y, kw.z, kw.w}, vv[4] = {vw.x, vw.y, vw.z, vw.w};
#pragma unroll
              for (int j = 0; j < 4; ++j) { const float k0 = bf_lo(kk[j]), k1 = bf_hi(kk[j]); const int r0 = (eg * 8 + 2 * j) * TS + s, r1 = r0 + TS;
                  KfT[r0] = f2bf(k0 * wf); KfT[r1] = f2bf(k1 * wf); KbT[r0] = f2bf(k0 * wb); KbT[r1] = f2bf(k1 * wb);
                  VT[r0] = (bf16_t)(vv[j] & 0xffffu); VT[r1] = (bf16_t)(vv[j] >> 16); } } }
        __syncthreads();
#pragma unroll
        for (int dir = 0; dir < 2; ++dir) {
            f32x4 acc[4][2]; zero_acc(acc);
            mm128(acc, VT, dir ? KbT : KfT, wr, wc, fr, fq);
            bf16_t* dst = KV + ((size_t)((dir * 16 + bh) * 128 + n)) * 16384;
#pragma unroll
            for (int m = 0; m < 4; ++m)
#pragma unroll
                for (int nn = 0; nn < 2; ++nn) { const int e = 64 * wr + 16 * m + fr, d = 32 * wc + 16 * nn + 4 * fq;
                    u32x2 w; w.x = cvt_pk_bf16(acc[m][nn][0], acc[m][nn][1]); w.y = cvt_pk_bf16(acc[m][nn][2], acc[m][nn][3]);
                    *(u32x2*)(dst + e * 128 + d) = w; }
        }
    }
}

__device__ void phase_conv(const Params& p) {
    const int tid = threadIdx.x; const int cg4 = tid & 255, half = tid >> 8;
    const unsigned* UW = (const unsigned*)(p.ws + WS_UW); bf16_t* BR1 = (bf16_t*)(p.ws + WS_BR) + (size_t)T_TOK * 1024;
    const f32x4 k0 = *(const f32x4*)(p.conv_w + cg4 * 4), k1 = *(const f32x4*)(p.conv_w + 1024 + cg4 * 4), k2 = *(const f32x4*)(p.conv_w + 2048 + cg4 * 4);
    for (int unit = blockIdx.x; unit < 512; unit += gridDim.x) {
        const int tb = unit * 64 + half * 32;
        for (int bt = 0; bt < 4; ++bt) {
            const int t0 = tb + bt * 8;
            u32x4 r[10];
#pragma unroll
            for (int j = 0; j < 10; ++j) {
                const bool valid = !((j == 0 && (t0 & (SEQ - 1)) == 0) || (j == 9 && ((t0 + 8) & (SEQ - 1)) == 0));
                r[j] = valid ? *(const u32x4*)(UW + (size_t)(t0 - 1 + j) * 1024 + cg4 * 4) : (u32x4){0u, 0u, 0u, 0u}; }
#pragma unroll
            for (int i = 0; i < 8; ++i) {
                const u32x4 prev = r[i], cur = r[i + 1], nxt = r[i + 2];
                const float c0 = k0[0] * bf_lo(prev.x) + k1[0] * bf_lo(cur.x) + k2[0] * bf_lo(nxt.x);
                const float c1 = k0[1] * bf_lo(prev.y) + k1[1] * bf_lo(cur.y) + k2[1] * bf_lo(nxt.y);
                const float c2 = k0[2] * bf_lo(prev.z) + k1[2] * bf_lo(cur.z) + k2[2] * bf_lo(nxt.z);
                const float c3 = k0[3] * bf_lo(prev.w) + k1[3] * bf_lo(cur.w) + k2[3] * bf_lo(nxt.w);
                u32x2 w; w.x = cvt_pk_bf16(c0 * bf_hi(cur.x), c1 * bf_hi(cur.y)); w.y = cvt_pk_bf16(c2 * bf_hi(cur.z), c3 * bf_hi(cur.w));
                *(u32x2*)(BR1 + (size_t)(t0 + i) * 1024 + cg4 * 4) = w;
            }
        }
    }
}

__device__ void phase_scan(const Params& p) {
    const int tid = threadIdx.x;
    const bf16_t* KV = (const bf16_t*)(p.ws + WS_KV); bf16_t* ST = (bf16_t*)(p.ws + WS_ST);
    for (int item = blockIdx.x * 512 + tid; item < 131072; item += gridDim.x * 512) {
        const int q = item & 4095, bh = (item >> 12) & 15, dir = item >> 16, h = bh & 7;
        const float lg = ((const float*)(p.ws + WS_LG))[dir * 8 + h];
        const float a = exp2f(128.0f * lg);
        const size_t base = (size_t)((dir * 16 + bh) * 128) * 16384 + (size_t)q * 4;
        float s0 = 0.f, s1 = 0.f, s2 = 0.f, s3 = 0.f;
        for (int step = 0; step < 128; step += 8) {
            u32x2 kv[8];
#pragma unroll
            for (int j = 0; j < 8; ++j) { const int n = dir ? 127 - (step + j) : (step + j); kv[j] = *(const u32x2*)(KV + base + (size_t)n * 16384); }
#pragma unroll
            for (int j = 0; j < 8; ++j) { const int n = dir ? 127 - (step + j) : (step + j);
                u32x2 w; w.x = cvt_pk_bf16(s0, s1); w.y = cvt_pk_bf16(s2, s3); *(u32x2*)(ST + base + (size_t)n * 16384) = w;
                s0 = a * s0 + bf_lo(kv[j].x); s1 = a * s1 + bf_hi(kv[j].x); s2 = a * s2 + bf_lo(kv[j].y); s3 = a * s3 + bf_hi(kv[j].y); }
        }
    }
}

__device__ __forceinline__ void ld_nat(u32x4 (&r)[4], const bf16_t* src, size_t ld, int tid) {
#pragma unroll
    for (int it = 0; it < 4; ++it) { const int idx = tid + 512 * it, row = idx >> 4, cg8 = idx & 15; r[it] = *(const u32x4*)(src + (size_t)row * ld + cg8 * 8); }
}
__device__ __forceinline__ void st_nat(LAS bf16_t* dst, const u32x4 (&r)[4], int tid) {
#pragma unroll
    for (int it = 0; it < 4; ++it) { const int idx = tid + 512 * it, row = idx >> 4, cg8 = idx & 15; *(LAS u32x4*)(dst + row * TS + cg8 * 8) = r[it]; }
}
__device__ __forceinline__ void ld_tr(u32x4 (&r)[4], const bf16_t* src, int tid) {
    const int s = tid & 127, eg0 = tid >> 7;
#pragma unroll
    for (int it = 0; it < 4; ++it) r[it] = *(const u32x4*)(src + (size_t)s * 1024 + (eg0 + 4 * it) * 8);
}
__device__ __forceinline__ void st_tr(LAS bf16_t* dst, const u32x4 (&r)[4], int tid) {
    const int s = tid & 127, eg0 = tid >> 7;
#pragma unroll
    for (int it = 0; it < 4; ++it) { const int eg = eg0 + 4 * it; const unsigned vv[4] = {r[it].x, r[it].y, r[it].z, r[it].w};
#pragma unroll
        for (int j = 0; j < 4; ++j) { const int r0 = (eg * 8 + 2 * j) * TS + s; dst[r0] = (bf16_t)(vv[j] & 0xffffu); dst[r0 + TS] = (bf16_t)(vv[j] >> 16); } }
}

__device__ void phase_r3(const Params& p, LAS unsigned char* lds) {
    const int tid = threadIdx.x, wid = __builtin_amdgcn_readfirstlane(tid >> 6), lane = tid & 63, wr = wid >> 2, wc = wid & 3, fr = lane & 15, fq = lane >> 4;
    LAS bf16_t* Qs = (LAS bf16_t*)lds; LAS bf16_t* Ks = Qs + 128 * TS; LAS bf16_t* VT = Ks + 128 * TS; LAS bf16_t* Ss = VT + 128 * TS; LAS float* red = (LAS float*)(Ss + 128 * TS);
    const bf16_t* Qg = (const bf16_t*)(p.ws + WS_Q); const bf16_t* Kg = (const bf16_t*)(p.ws + WS_K); const bf16_t* Vg = (const bf16_t*)(p.ws + WS_V);
    const bf16_t* SG = (const bf16_t*)(p.ws + WS_SG); const bf16_t* ST = (const bf16_t*)(p.ws + WS_ST); bf16_t* BR0 = (bf16_t*)(p.ws + WS_BR);
    const int G = gridDim.x;
    u32x4 rq[4], rk[4];
    { const int unit = blockIdx.x;
      if (unit < 2048) { const int bh = unit >> 7, n = unit & 127, b = bh >> 3, h = bh & 7; const size_t rowbase = (size_t)b * SEQ + (size_t)n * 128;
        ld_nat(rq, Qg + rowbase * 1024 + h * 128, 1024, tid); ld_nat(rk, Kg + rowbase * 1024 + h * 128, 1024, tid); } }
    for (int unit = blockIdx.x; unit < 2048; unit += G) {
        const int bh = unit >> 7, n = unit & 127, b = bh >> 3, h = bh & 7;
        const float lgf = ((const float*)(p.ws + WS_LG))[h], lgb = ((const float*)(p.ws + WS_LG))[8 + h];
        const size_t rowbase = (size_t)b * SEQ + (size_t)n * 128;
        u32x4 rv[4], rs[4], rb[4];
        ld_tr(rv, Vg + rowbase * 1024 + h * 128, tid); ld_nat(rs, ST + ((size_t)((0 * 16 + bh) * 128 + n)) * 16384, 128, tid);
        ld_nat(rb, ST + ((size_t)((1 * 16 + bh) * 128 + n)) * 16384, 128, tid);
        u32x2 sg[4][2];
#pragma unroll
        for (int nn = 0; nn < 2; ++nn) { const int e0 = 32 * wc + 16 * nn + 4 * fq;
#pragma unroll
            for (int m = 0; m < 4; ++m) sg[m][nn] = *(const u32x2*)(SG + (rowbase + 64 * wr + 16 * m + fr) * 1024 + h * 128 + e0); }
        __builtin_amdgcn_sched_barrier(0);
        __syncthreads();
        st_nat(Qs, rq, tid); st_nat(Ks, rk, tid); st_nat(Ss, rs, tid); st_tr(VT, rv, tid);
        __builtin_amdgcn_sched_barrier(0);
        __syncthreads();
        f32x4 accP[4][2], acc1[4][2], acc2[4][2];
        zero_acc(accP); mm128(accP, Qs, Ks, wr, wc, fr, fq);
        float rowf[4], rowb[4], colf[2][4], colb[2][4];
#pragma unroll
        for (int m = 0; m < 4; ++m) { const float tf = (float)(64 * wr + 16 * m + fr); rowf[m] = __builtin_amdgcn_exp2f(tf * lgf); rowb[m] = __builtin_amdgcn_exp2f(-tf * lgb); }
#pragma unroll
        for (int nn = 0; nn < 2; ++nn)
#pragma unroll
            for (int j = 0; j < 4; ++j) { const float sf = (float)(32 * wc + 16 * nn + 4 * fq + j); colf[nn][j] = __builtin_amdgcn_exp2f(-sf * lgf); colb[nn][j] = __builtin_amdgcn_exp2f(sf * lgb); }
#pragma unroll
        for (int m = 0; m < 4; ++m)
#pragma unroll
            for (int nn = 0; nn < 2; ++nn)
#pragma unroll
                for (int j = 0; j < 4; ++j) { const int t = 64 * wr + 16 * m + fr, s = 32 * wc + 16 * nn + 4 * fq + j;
                    accP[m][nn][j] *= (s <= t) ? rowf[m] * colf[nn][j] : rowb[m] * colb[nn][j]; }
        zero_acc(acc1); mm128(acc1, Qs, Ss, wr, wc, fr, fq);
#pragma unroll
        for (int m = 0; m < 4; ++m)
#pragma unroll
            for (int nn = 0; nn < 2; ++nn) acc1[m][nn] *= rowf[m];
        __syncthreads();
#pragma unroll
        for (int m = 0; m < 4; ++m)
#pragma unroll
            for (int nn = 0; nn < 2; ++nn) { const int t = 64 * wr + 16 * m + fr, s = 32 * wc + 16 * nn + 4 * fq;
                u32x2 w; w.x = cvt_pk_bf16(accP[m][nn][0], accP[m][nn][1]); w.y = cvt_pk_bf16(accP[m][nn][2], accP[m][nn][3]);
                *(LAS u32x2*)(Ks + t * TS + s) = w; }
        st_nat(Ss, rb, tid);
        __builtin_amdgcn_sched_barrier(0);
        { const int nu = unit + G;
          if (nu < 2048) { const int bh2 = nu >> 7, n2 = nu & 127, b2 = bh2 >> 3, h2 = bh2 & 7; const size_t rowbase2 = (size_t)b2 * SEQ + (size_t)n2 * 128;
            ld_nat(rq, Qg + rowbase2 * 1024 + h2 * 128, 1024, tid); ld_nat(rk, Kg + rowbase2 * 1024 + h2 * 128, 1024, tid); } }
        __builtin_amdgcn_sched_barrier(0);
        __syncthreads();
        zero_acc(acc2); mm128(acc2, Qs, Ss, wr, wc, fr, fq);
        { const float g127 = __builtin_amdgcn_exp2f(127.0f * lgb);
#pragma unroll
          for (int m = 0; m < 4; ++m) { const float sc = g127 * rowb[m];
#pragma unroll
            for (int nn = 0; nn < 2; ++nn) acc1[m][nn] += acc2[m][nn] * sc; } }
        mm128(acc1, Ks, VT, wr, wc, fr, fq);
#pragma unroll
        for (int m = 0; m < 4; ++m) { float ss = 0.f;
#pragma unroll
            for (int nn = 0; nn < 2; ++nn) ss += (acc1[m][nn][0] * acc1[m][nn][0] + acc1[m][nn][1] * acc1[m][nn][1]) + (acc1[m][nn][2] * acc1[m][nn][2] + acc1[m][nn][3] * acc1[m][nn][3]);
            ss += __shfl_xor(ss, 16); ss += __shfl_xor(ss, 32);
            if (fq == 0) red[(64 * wr + 16 * m + fr) * 4 + wc] = ss; }
        __syncthreads();
#pragma unroll
        for (int m = 0; m < 4; ++m) { const int t = 64 * wr + 16 * m + fr; const f32x4 r4 = *(const LAS f32x4*)(red + t * 4);
            const float rstd = __builtin_amdgcn_rsqf(((r4[0] + r4[1]) + (r4[2] + r4[3])) * (1.0f / 128.0f) + 1e-6f);
#pragma unroll
            for (int nn = 0; nn < 2; ++nn) { const int e0 = 32 * wc + 16 * nn + 4 * fq; const f32x4 gg = *(const f32x4*)(p.gn_gain + h * 128 + e0);
                u32x2 w; w.x = cvt_pk_bf16(acc1[m][nn][0] * rstd * gg[0] * bf_lo(sg[m][nn].x), acc1[m][nn][1] * rstd * gg[1] * bf_hi(sg[m][nn].x));
                w.y = cvt_pk_bf16(acc1[m][nn][2] * rstd * gg[2] * bf_lo(sg[m][nn].y), acc1[m][nn][3] * rstd * gg[3] * bf_hi(sg[m][nn].y));
                *(u32x2*)(BR0 + (rowbase + t) * 1024 + h * 128 + e0) = w; } }
    }
}

__device__ void phase_final(const Params& p) {
    const int tid = threadIdx.x, lane = tid & 63, wv = tid >> 6; const float* SSQ = (const float*)(p.ws + WS_SSQ);
    f32x4 g[8];
#pragma unroll
    for (int i = 0; i < 8; ++i) g[i] = *(const f32x4*)(p.final_gain + i * 256 + lane * 4);
    for (int row = (blockIdx.x * 8 + wv) * 2; row < T_TOK; row += gridDim.x * 16) {
        float ss[2]; f32x4 y[2][8];
#pragma unroll
        for (int r = 0; r < 2; ++r) { ss[r] = lane < 32 ? SSQ[(size_t)(row + r) * 32 + lane] : 0.f;
#pragma unroll
            for (int i = 0; i < 8; ++i) y[r][i] = *(const f32x4*)(p.out + (size_t)(row + r) * DM + i * 256 + lane * 4); }
#pragma unroll
        for (int r = 0; r < 2; ++r) {
#pragma unroll
            for (int o = 32; o >= 1; o >>= 1) ss[r] += __shfl_xor(ss[r], o);
            const float rstd = rsqrtf(ss[r] * (1.0f / 2048.0f) + 1e-6f);
#pragma unroll
            for (int i = 0; i < 8; ++i) *(f32x4*)(p.out + (size_t)(row + r) * DM + i * 256 + lane * 4) = y[r][i] * rstd * g[i]; }
    }
}


#define XB_TMO      128
#define XB_XCNT(j)  (256  + 64 * (j))
#define XB_XSUB(j)  (1280 + 64 * (j))
#define XB_XGEN(j)  (2304 + 64 * (j))
#define XB_TOP      3328
#define XB_TOPGEN   3392
#define XCD_BAR_WORDS 3456
#define XB_SPIN_CAP (1u << 18)
__device__ __forceinline__ unsigned xb_ld(unsigned* p)              { return __hip_atomic_load(p, __ATOMIC_RELAXED, __HIP_MEMORY_SCOPE_AGENT); }
__device__ __forceinline__ unsigned xb_add(unsigned* p, unsigned v) { return __hip_atomic_fetch_add(p, v, __ATOMIC_RELAXED, __HIP_MEMORY_SCOPE_AGENT); }
__device__ __forceinline__ unsigned xb_xcc_id() { return (unsigned)__builtin_amdgcn_s_getreg((3 << 11) | 20) & 0xFu; }
#define XB_SPIN(cond, bar) do { unsigned _sp = 0; while (cond) { __builtin_amdgcn_s_sleep(1); \
    if ((++_sp & 255u) == 0u) { if (xb_ld(&(bar)[XB_TMO])) break; if (_sp > XB_SPIN_CAP) { atomicAdd(&(bar)[XB_TMO], 1u); break; } } } } while (0)
struct XcdBarrier { unsigned* bar; unsigned x; volatile LAS unsigned* st; };
__device__ __forceinline__ XcdBarrier xcd_barrier_post(unsigned* bar, volatile LAS unsigned* st) {
    XcdBarrier b; b.bar = bar; b.x = xb_xcc_id(); b.st = st;
    if (threadIdx.x == 0) (void)xb_add(&bar[XB_XCNT(b.x)], 1u);
    return b;
}
__device__ __forceinline__ void xcd_barrier_complete(unsigned* bar, unsigned x, unsigned& nloc, unsigned& nx) {
    const unsigned G = gridDim.x * gridDim.y * gridDim.z;
    unsigned sum, cnt, mine, sp = 0u;
    for (;;) {
        sum = 0u; cnt = 0u; mine = 0u;
#pragma unroll
        for (unsigned j = 0; j < 16; ++j) { const unsigned c = xb_ld(&bar[XB_XCNT(j)]); sum += c; cnt += (c > 0u) ? 1u : 0u; mine = (j == x) ? c : mine; }
        if (sum == G) break;
        __builtin_amdgcn_s_sleep(1);
        if ((++sp & 255u) == 0u) { if (xb_ld(&bar[XB_TMO])) break; if (sp > XB_SPIN_CAP) { atomicAdd(&bar[XB_TMO], 1u); break; } }
    }
    nloc = mine > 0u ? mine : 1u; nx = cnt > 0u ? cnt : 1u;
}
__device__ __forceinline__ void xcd_barrier(const XcdBarrier& b) {
    asm volatile("s_waitcnt vmcnt(0)" ::: "memory");
    __syncthreads();
    if (threadIdx.x == 0) {
        unsigned* bar = b.bar;
        __builtin_amdgcn_s_waitcnt(0);
        unsigned nloc = b.st[0], nx = b.st[1];
        if (nloc == 0u) { xcd_barrier_complete(bar, b.x, nloc, nx); b.st[0] = nloc; b.st[1] = nx; }
        const unsigned old = xb_add(&bar[XB_XSUB(b.x)], 1u);
        const unsigned gen = old / nloc;
        if (old + 1u == (gen + 1u) * nloc) {
            __builtin_amdgcn_fence(__ATOMIC_RELEASE, "agent");
            asm volatile("s_waitcnt vmcnt(0)" ::: "memory");
            const unsigned og = xb_add(&bar[XB_TOP], 1u);
            const unsigned tg = og / nx;
            if (og + 1u == (tg + 1u) * nx) xb_add(&bar[XB_TOPGEN], 1u);
            else XB_SPIN(xb_ld(&bar[XB_TOPGEN]) == tg, bar);
            __builtin_amdgcn_fence(__ATOMIC_ACQUIRE, "agent");
            xb_add(&bar[XB_XGEN(b.x)], 1u);
            asm volatile("s_waitcnt vmcnt(0)" ::: "memory");
        } else {
            XB_SPIN(xb_ld(&bar[XB_XGEN(b.x)]) == gen, bar);
            __builtin_amdgcn_fence(__ATOMIC_ACQUIRE, "agent");
            asm volatile("s_waitcnt vmcnt(0)" ::: "memory");
        }
    }
    __syncthreads();
}

__device__ __forceinline__ void grid_barrier(cg::grid_group& grid) {
    asm volatile("s_waitcnt vmcnt(0) lgkmcnt(0)" ::: "memory");
    grid.sync();
    __builtin_amdgcn_fence(__ATOMIC_ACQUIRE, "agent");
    asm volatile("s_waitcnt vmcnt(0)" ::: "memory");
}

__global__ void __launch_bounds__(512, 2) fwd_megakernel(Params p) {
    extern __shared__ __attribute__((aligned(16))) unsigned char lds_raw[];
    LAS unsigned char* lds = (LAS unsigned char*)lds_raw;
    cg::grid_group grid = cg::this_grid();
    unsigned char* ws = p.ws;
    const int G = gridDim.x, c = blockIdx.x;
    volatile LAS unsigned* xst = (volatile LAS unsigned*)(lds + LDS_BYTES - 16);
    if (threadIdx.x < 2) xst[threadIdx.x] = 0u;
    __syncthreads();
    const XcdBarrier xbar = xcd_barrier_post((unsigned*)(ws + WS_BAR), xst);

#ifndef PHM
#define PHM 255
#endif
    if (PHM & 1) phase_prologue(p, lds);
    grid_barrier(grid);
    if (PHM & 2) {
        pg8::Gemm g{(const bf16_t*)(ws + WS_H), (const bf16_t*)(ws + WS_WIN), T_TOK, NCOL, 2048, 0, 0};
        pg8::Order S; S.init(T_TOK, NCOL, G, c, 0);
        Epi1 E{(bf16_t*)(ws + WS_Q), (bf16_t*)(ws + WS_K), (bf16_t*)(ws + WS_V), (bf16_t*)(ws + WS_SG), (bf16_t*)(ws + WS_UW), (bf16_t*)(ws + WS_GATE), (const float*)(ws + WS_COS), (const float*)(ws + WS_SIN)};
        pg8::gemm_phase<Epi1>(lds, g, S, E);
    }
    xcd_barrier(xbar);
    if (PHM & 4) phase_r1(p, lds);
    if (PHM & 4) phase_conv(p);
    xcd_barrier(xbar);
    if (PHM & 8) phase_scan(p);
    xcd_barrier(xbar);
    if (PHM & 16) phase_r3(p, lds);
    xcd_barrier(xbar);
    if (PHM & 32) {
        pg8::Gemm g{(const bf16_t*)(ws + WS_BR), (const bf16_t*)(ws + WS_WB), T_TOK, 2048, 1024, (size_t)T_TOK * 1024 * 2, (size_t)2048 * 1024 * 2};
        pg8::Order S; S.init(T_TOK, 2048, G, c, 1);
        Epi2 E{(const bf16_t*)(ws + WS_GATE), (bf16_t*)(ws + WS_MERGED)};
        pg8::gemm_phase<Epi2>(lds, g, S, E);
    }
    xcd_barrier(xbar);
    if (PHM & 64) {
        pg8::Gemm g{(const bf16_t*)(ws + WS_MERGED), (const bf16_t*)(ws + WS_WO), T_TOK, 2048, 2048, 0, 0};
        pg8::Order S; S.init(T_TOK, 2048, G, c, 0);
        Epi3 E{p.x, p.out, (float*)(ws + WS_SSQ)};
        pg8::gemm_phase<Epi3>(lds, g, S, E);
    }
    xcd_barrier(xbar);
    if (PHM & 128) phase_final(p);
}

extern "C" void kernel_launch(void* const* d_in, const int* in_sizes, int n_in, void* d_out, int out_size, void* d_ws, size_t ws_size, hipStream_t stream) {
    static int grid_blocks = 0;
    if (!grid_blocks) {
        if (n_in != 10 || out_size != T_TOK * DM || ws_size < WS_END) { fprintf(stderr, "kernel_launch: unexpected shapes (n_in %d out %d ws %zu)\n", n_in, out_size, ws_size); grid_blocks = -1; return; }
        int dev = 0, cus = 0, per_cu = 0;
        hipGetDevice(&dev);
        hipDeviceGetAttribute(&cus, hipDeviceAttributeMultiprocessorCount, dev);
        if (hipFuncSetAttribute((const void*)fwd_megakernel, hipFuncAttributeMaxDynamicSharedMemorySize, LDS_BYTES) != hipSuccess) { fprintf(stderr, "kernel_launch: hipFuncSetAttribute failed\n"); grid_blocks = -1; return; }
        hipOccupancyMaxActiveBlocksPerMultiprocessor(&per_cu, (const void*)fwd_megakernel, 512, LDS_BYTES);
        if (per_cu < 1) { fprintf(stderr, "kernel_launch: occupancy query says %d blocks per CU\n", per_cu); per_cu = 1; }
        grid_blocks = cus * per_cu;
    }
    if (grid_blocks < 0) return;
    Params p{};
    p.x = (const float*)d_in[0]; p.norm_gain = (const float*)d_in[1]; p.w_in = (const float*)d_in[2]; p.lg_f = (const float*)d_in[3]; p.lg_b = (const float*)d_in[4];
    p.gn_gain = (const float*)d_in[5]; p.conv_w = (const float*)d_in[6]; p.w_branch = (const float*)d_in[7]; p.w_out = (const float*)d_in[8]; p.final_gain = (const float*)d_in[9];
    p.out = (float*)d_out; p.ws = (unsigned char*)d_ws;
    if (hipMemsetAsync((char*)d_ws + WS_BAR, 0, XCD_BAR_WORDS * 4, stream) != hipSuccess) { fprintf(stderr, "kernel_launch: memset of barrier words failed\n"); return; }
    void* args[] = {&p};
    hipError_t e = hipLaunchCooperativeKernel((const void*)fwd_megakernel, dim3(grid_blocks), dim3(512), args, LDS_BYTES, stream);
    if (e != hipSuccess) fprintf(stderr, "cooperative launch failed: %s (grid %d)\n", hipGetErrorString(e), grid_blocks);
}
```

```cpp
#include <hip/hip_runtime.h>
#include <hip/hip_cooperative_groups.h>
#include <cstdio>
namespace cg = cooperative_groups;

#define LAS __attribute__((address_space(3)))
typedef unsigned short bf16_t;
typedef short bf16x8 __attribute__((ext_vector_type(8)));
typedef float f32x4 __attribute__((ext_vector_type(4)));
typedef unsigned u32x4 __attribute__((ext_vector_type(4)));
typedef unsigned u32x2 __attribute__((ext_vector_type(2)));

constexpr int T_TOK = 32768, DM = 2048, SEQ = 16384, NCOL = 12288;
constexpr size_t MiB = 1ull << 20;
constexpr size_t WS_H = 0, WS_KV = 0, WS_WIN = 128 * MiB, WS_WB = 176 * MiB, WS_WO = 184 * MiB, WS_COS = 192 * MiB, WS_SIN = 196 * MiB,
                 WS_Q = 200 * MiB, WS_K = 264 * MiB, WS_MERGED = 200 * MiB, WS_V = 328 * MiB, WS_SG = 392 * MiB, WS_UW = 456 * MiB, WS_ST = 456 * MiB,
                 WS_GATE = 584 * MiB, WS_BR = 840 * MiB, WS_SSQ = 968 * MiB, WS_LG = 972 * MiB, WS_BAR = 972 * MiB + 65536, WS_END = 973 * MiB;
constexpr int LDS_BYTES = 147456;
constexpr int TS = 136;

struct Params {
    const float* x; const float* norm_gain; const float* w_in; const float* lg_f; const float* lg_b; const float* gn_gain;
    const float* conv_w; const float* w_branch; const float* w_out; const float* final_gain; float* out; unsigned char* ws;
};

typedef __bf16 bf16x2_t __attribute__((ext_vector_type(2)));
typedef float f32x2_t __attribute__((ext_vector_type(2)));
__device__ __forceinline__ unsigned cvt_pk_bf16(float lo, float hi) { f32x2_t v = {lo, hi}; bf16x2_t b = __builtin_convertvector(v, bf16x2_t); return __builtin_bit_cast(unsigned, b); }
__device__ __forceinline__ bf16_t f2bf(float f) { unsigned u = __float_as_uint(f); u += 0x7FFFu + ((u >> 16) & 1u); return (bf16_t)(u >> 16); }
__device__ __forceinline__ float bf_lo(unsigned w) { return __uint_as_float(w << 16); }
__device__ __forceinline__ float bf_hi(unsigned w) { return __uint_as_float(w & 0xffff0000u); }
__device__ __forceinline__ float sigmoidf_(float x) { return __builtin_amdgcn_rcpf(1.0f + __expf(-x)); }
__device__ __forceinline__ float log2_sigmoid(float x) { return -log1pf(expf(-x)) * 1.4426950408889634f; }

namespace pg8 {
constexpr int BM = 256, BK = 64, HALF = 128, HTB = HALF * BK * 2, STAGE_BYTES = 8 * HTB, NXCD = 8, WGM = 8;
__host__ __device__ __forceinline__ int lds_byte(int r, int c) { const int st = (r >> 4) * 2 + (c >> 5), rr = r & 15, cc = c & 31, ob = rr * 64 + cc * 2; return st * 1024 + (ob ^ (((ob >> 9) & 1) << 5)); }
__host__ __device__ __forceinline__ void stage_rc(int b, int& R, int& C) { const int st = b / 1024, sb = b % 1024, swz = sb ^ (((sb >> 9) & 1) << 5); R = (st >> 1) * 16 + swz / 64; C = (st & 1) * 32 + (swz % 64) / 2; }
__host__ __device__ __forceinline__ int perm32(int rho) { const int n = rho >> 4, i = rho & 15; return 8 * (i >> 2) + 4 * n + (i & 3); }

struct Unit { int pm, pn, z; };
struct Gemm { const bf16_t* A; const bf16_t* Bt; int M, N, K; size_t zA, zB; };

struct Order {
    int nM, nN, nwg, G, c, zsh;
    __device__ void init(int M, int N, int G_, int c_, int zsh_) { nM = M / BM; nN = N / BM; nwg = nM * nN; G = G_; c = c_; zsh = zsh_; }
    __device__ bool next(int i, Unit& u) const {
        const int ti = i >> zsh; u.z = i & ((1 << zsh) - 1);
        const long L = (long)ti * G + c; if (L >= nwg) return false;
        int wgid = (int)L; { const int q = nwg / NXCD, r = nwg % NXCD, xcd = wgid % NXCD, off = wgid / NXCD; wgid = (xcd < r ? xcd * (q + 1) : r * (q + 1) + (xcd - r) * q) + off; }
        const int nig = WGM * nN, gid = wgid / nig, fm = gid * WGM, gsz = (nM - fm) < WGM ? (nM - fm) : WGM;
        u.pm = fm + ((wgid % nig) % gsz); u.pn = (wgid % nig) / gsz; return true;
    }
};

template <class Epi>
__device__ __forceinline__ void gemm_phase(LAS unsigned char* lds, const Gemm g, const Order& S, const Epi& E) {
    const int tid = threadIdx.x, wid = __builtin_amdgcn_readfirstlane(tid >> 6), lane = tid & 63, wr = wid >> 2, wc = wid & 3, fr = lane & 15, fq = lane >> 4;
    const int K = g.K, nt = K / BK;
    unsigned voffA[2], voffB[2];
#pragma unroll
    for (int i = 0; i < 2; ++i) { int R, C; stage_rc(tid * 16 + i * 8192, R, C); const int Rb = Epi::PERM ? ((R & ~31) + perm32(R & 31)) : R;
        voffA[i] = (unsigned)(R * K + C) * 2u; voffB[i] = (unsigned)(Rb * K + C) * 2u; }
    const size_t kstep = (size_t)(BK * 2);
    const size_t hstep = (size_t)HALF * K * 2;
    const size_t tstep = 2 * hstep;
    const unsigned ldsw = (unsigned)wid * 1024u;
    const int aoff = lds_byte(wr * 64 + fr, fq * 8), boff = lds_byte(wc * 32 + fr, fq * 8);
#define PG8_SA(b, h) (((b) * 2 + (h)) * HTB)
#define PG8_SB(b, h) ((4 + (b) * 2 + (h)) * HTB)
#define PG8_STAGE(bufoff, gbase, voff) do { _Pragma("unroll") for (int _i = 0; _i < 2; ++_i) \
        __builtin_amdgcn_global_load_lds((const unsigned*)((const char*)(gbase) + (voff)[_i]), (LAS unsigned*)(lds + (bufoff) + ldsw + _i * 8192), 16, 0, 0); } while (0)
#define PG8_LDA(dst, b, h) do { _Pragma("unroll") for (int m = 0; m < 4; ++m) _Pragma("unroll") for (int k = 0; k < 2; ++k) dst[m][k] = *(const LAS bf16x8*)(lds + PG8_SA(b, h) + aoff + m * 2048 + k * 1024); } while (0)
#define PG8_LDB(dst, b, h) do { _Pragma("unroll") for (int n = 0; n < 2; ++n) _Pragma("unroll") for (int k = 0; k < 2; ++k) dst[n][k] = *(const LAS bf16x8*)(lds + PG8_SB(b, h) + boff + n * 2048 + k * 1024); } while (0)
#define PG8_MMA(ai, bj, At, Bt) do { __builtin_amdgcn_s_setprio(1); _Pragma("unroll") for (int m = 0; m < 4; ++m) _Pragma("unroll") for (int n = 0; n < 2; ++n) _Pragma("unroll") for (int k = 0; k < 2; ++k) \
        acc[ai][bj][m][n] = __builtin_amdgcn_mfma_f32_16x16x32_bf16(Bt[n][k], At[m][k], acc[ai][bj][m][n], 0, 0, 0); __builtin_amdgcn_s_setprio(0); } while (0)
#define PG8_WAIT_V(n) asm volatile("s_waitcnt vmcnt(" #n ")" ::: "memory")
#define PG8_WAIT_L(n) asm volatile("s_waitcnt lgkmcnt(" #n ")" ::: "memory")
#define PG8_BAR __builtin_amdgcn_s_barrier()
#define PG8_SCHED __builtin_amdgcn_sched_barrier(0)
    Unit cur, nxt; int ui = 0;
    if (!S.next(0, cur)) return;
    f32x4 acc[2][2][4][2];
#pragma unroll
    for (int a = 0; a < 2; ++a)
#pragma unroll
        for (int b = 0; b < 2; ++b)
#pragma unroll
            for (int m = 0; m < 4; ++m)
#pragma unroll
                for (int n = 0; n < 2; ++n) acc[a][b][m][n] = (f32x4){0.f, 0.f, 0.f, 0.f};
    bf16x8 At[4][2], B0[2][2], B1[2][2];
    const char* cA = (const char*)g.A + (size_t)cur.pm * tstep + (size_t)cur.z * g.zA; const char* cB = (const char*)g.Bt + (size_t)cur.pn * tstep + (size_t)cur.z * g.zB;
    PG8_STAGE(PG8_SB(0, 0), cB, voffB); PG8_STAGE(PG8_SA(0, 0), cA, voffA); PG8_STAGE(PG8_SB(0, 1), cB + hstep, voffB); PG8_STAGE(PG8_SA(0, 1), cA + hstep, voffA);
    if (wr == 1) PG8_BAR;
    PG8_WAIT_V(4); PG8_BAR;
    PG8_STAGE(PG8_SB(1, 0), cB + kstep, voffB); PG8_STAGE(PG8_SA(1, 0), cA + kstep, voffA); PG8_STAGE(PG8_SB(1, 1), cB + hstep + kstep, voffB);
    PG8_WAIT_V(6); PG8_BAR;
    for (;;) {
        const bool has_next = S.next(ui + 1, nxt);
        const char* nA = has_next ? (const char*)g.A + (size_t)nxt.pm * tstep + (size_t)nxt.z * g.zA : cA;
        const char* nB = has_next ? (const char*)g.Bt + (size_t)nxt.pn * tstep + (size_t)nxt.z * g.zB : cB;
        for (int t = 0; t < nt; t += 2) {
            const bool last = (t == nt - 2);
            const char* a1 = cA + (size_t)(t + 1) * kstep;
            const char* a2 = last ? nA : cA + (size_t)(t + 2) * kstep; const char* b2 = last ? nB : cB + (size_t)(t + 2) * kstep;
            const char* a3 = a2 + kstep; const char* b3 = b2 + kstep;
            PG8_LDB(B0, 0, 0); PG8_SCHED; PG8_LDA(At, 0, 0); PG8_STAGE(PG8_SA(1, 1), a1 + hstep, voffA);
            PG8_WAIT_L(8); PG8_BAR; PG8_WAIT_L(0); PG8_MMA(0, 0, At, B0); PG8_BAR; PG8_SCHED;
            PG8_LDB(B1, 0, 1); PG8_STAGE(PG8_SB(0, 0), b2, voffB);
            PG8_BAR; PG8_WAIT_L(0); PG8_MMA(0, 1, At, B1); PG8_BAR;
            PG8_LDA(At, 0, 1); PG8_STAGE(PG8_SA(0, 0), a2, voffA);
            PG8_BAR; PG8_WAIT_L(0); PG8_MMA(1, 0, At, B0); PG8_BAR; PG8_SCHED;
            PG8_STAGE(PG8_SB(0, 1), b2 + hstep, voffB);
            PG8_WAIT_V(6); PG8_BAR; PG8_MMA(1, 1, At, B1); PG8_BAR;
            PG8_LDB(B0, 1, 0); PG8_SCHED; PG8_LDA(At, 1, 0); PG8_STAGE(PG8_SA(0, 1), a2 + hstep, voffA);
            PG8_WAIT_L(8); PG8_BAR; PG8_WAIT_L(0); PG8_MMA(0, 0, At, B0); PG8_BAR; PG8_SCHED;
            PG8_LDB(B1, 1, 1); PG8_STAGE(PG8_SB(1, 0), b3, voffB);
            PG8_BAR; PG8_WAIT_L(0); PG8_MMA(0, 1, At, B1); PG8_BAR;
            PG8_LDA(At, 1, 1); PG8_STAGE(PG8_SA(1, 0), a3, voffA);
            PG8_BAR; PG8_WAIT_L(0); PG8_MMA(1, 0, At, B0); PG8_BAR; PG8_SCHED;
            PG8_STAGE(PG8_SB(1, 1), b3 + hstep, voffB);
            PG8_WAIT_V(6); PG8_BAR; PG8_MMA(1, 1, At, B1); PG8_BAR;
        }
        E(acc, cur, wr, wc, fr, fq);
        if (!has_next) break;
#pragma unroll
        for (int a = 0; a < 2; ++a)
#pragma unroll
            for (int b = 0; b < 2; ++b)
#pragma unroll
                for (int m = 0; m < 4; ++m)
#pragma unroll
                    for (int n = 0; n < 2; ++n) acc[a][b][m][n] = (f32x4){0.f, 0.f, 0.f, 0.f};
        cur = nxt; cA = nA; cB = nB; ++ui;
    }
    PG8_WAIT_V(0);
    if (wr == 0) PG8_BAR;
    PG8_BAR;
#undef PG8_SA
#undef PG8_SB
#undef PG8_STAGE
#undef PG8_LDA
#undef PG8_LDB
#undef PG8_MMA
#undef PG8_WAIT_V
#undef PG8_WAIT_L
#undef PG8_BAR
#undef PG8_SCHED
}
}

struct Epi1 {
    static constexpr bool PERM = true;
    bf16_t *Q, *K, *V, *SG, *UW, *GATE; const float *COS, *SIN;
    __device__ __forceinline__ void operator()(const f32x4 (&acc)[2][2][4][2], const pg8::Unit& u, int wr, int wc, int fr, int fq) const {
        const int row0 = u.pm * 256 + wr * 64 + fr, lc = wc * 32 + 8 * fq, pn = u.pn;
        if (pn < 8) {
            bf16_t* base = (pn < 4 ? Q : K) + (pn & 3) * 256 + lc;
            const int i0 = lc >> 1;
#pragma unroll
            for (int ai = 0; ai < 2; ++ai) {
                f32x4 cs[4], sn[4];
#pragma unroll
                for (int m = 0; m < 4; ++m) { const int pos = (row0 + ai * 128 + m * 16) & (SEQ - 1);
                    cs[m] = *(const f32x4*)(COS + pos * 64 + i0); sn[m] = *(const f32x4*)(SIN + pos * 64 + i0); }
#pragma unroll
                for (int m = 0; m < 4; ++m) {
                    const int row = row0 + ai * 128 + m * 16;
#pragma unroll
                    for (int bj = 0; bj < 2; ++bj) {
                        const f32x4 v0 = acc[ai][bj][m][0], v1 = acc[ai][bj][m][1]; u32x4 w;
                        w.x = cvt_pk_bf16(v0[0] * cs[m][0] - v0[1] * sn[m][0], v0[1] * cs[m][0] + v0[0] * sn[m][0]);
                        w.y = cvt_pk_bf16(v0[2] * cs[m][1] - v0[3] * sn[m][1], v0[3] * cs[m][1] + v0[2] * sn[m][1]);
                        w.z = cvt_pk_bf16(v1[0] * cs[m][2] - v1[1] * sn[m][2], v1[1] * cs[m][2] + v1[0] * sn[m][2]);
                        w.w = cvt_pk_bf16(v1[2] * cs[m][3] - v1[3] * sn[m][3], v1[3] * cs[m][3] + v1[2] * sn[m][3]);
                        *(u32x4*)(base + (size_t)row * 1024 + bj * 128) = w; }
                }
            }
        } else if (pn < 16) {
            const bool act = pn >= 12;
            bf16_t* base = (act ? SG : V) + (pn & 3) * 256 + lc;
#pragma unroll
            for (int ai = 0; ai < 2; ++ai)
#pragma unroll
                for (int m = 0; m < 4; ++m) {
                    const int row = row0 + ai * 128 + m * 16;
#pragma unroll
                    for (int bj = 0; bj < 2; ++bj) {
                        f32x4 v0 = acc[ai][bj][m][0], v1 = acc[ai][bj][m][1];
                        if (act) {
#pragma unroll
                            for (int j = 0; j < 4; ++j) { v0[j] = v0[j] * sigmoidf_(v0[j]); v1[j] = v1[j] * sigmoidf_(v1[j]); } }
                        u32x4 w; w.x = cvt_pk_bf16(v0[0], v0[1]); w.y = cvt_pk_bf16(v0[2], v0[3]); w.z = cvt_pk_bf16(v1[0], v1[1]); w.w = cvt_pk_bf16(v1[2], v1[3]);
                        *(u32x4*)(base + (size_t)row * 1024 + bj * 128) = w; }
                }
        } else if (pn < 32) {
            const int ch0 = 64 * (pn - 16) + 16 * wc + 4 * fq;
#pragma unroll
            for (int ai = 0; ai < 2; ++ai)
#pragma unroll
                for (int m = 0; m < 4; ++m) {
                    const int row = row0 + ai * 128 + m * 16;
                    const f32x4 cc = acc[ai][0][m][0], cx = acc[ai][0][m][1], cb = acc[ai][1][m][0], g = acc[ai][1][m][1];
                    u32x4 w;
                    w.x = cvt_pk_bf16(cc[0] * cx[0], cb[0] * g[0] * sigmoidf_(g[0]));
                    w.y = cvt_pk_bf16(cc[1] * cx[1], cb[1] * g[1] * sigmoidf_(g[1]));
                    w.z = cvt_pk_bf16(cc[2] * cx[2], cb[2] * g[2] * sigmoidf_(g[2]));
                    w.w = cvt_pk_bf16(cc[3] * cx[3], cb[3] * g[3] * sigmoidf_(g[3]));
                    *(u32x4*)(UW + ((size_t)row * 1024 + ch0) * 2) = w;
                }
        } else {
            bf16_t* base = GATE + (pn - 32) * 256 + lc;
#pragma unroll
            for (int ai = 0; ai < 2; ++ai)
#pragma unroll
                for (int m = 0; m < 4; ++m) {
                    const int row = row0 + ai * 128 + m * 16;
#pragma unroll
                    for (int bj = 0; bj < 2; ++bj) {
                        const f32x4 v0 = acc[ai][bj][m][0], v1 = acc[ai][bj][m][1];
                        u32x4 w; w.x = cvt_pk_bf16(sigmoidf_(v0[0]), sigmoidf_(v0[1])); w.y = cvt_pk_bf16(sigmoidf_(v0[2]), sigmoidf_(v0[3]));
                        w.z = cvt_pk_bf16(sigmoidf_(v1[0]), sigmoidf_(v1[1])); w.w = cvt_pk_bf16(sigmoidf_(v1[2]), sigmoidf_(v1[3]));
                        *(u32x4*)(base + (size_t)row * 4096 + bj * 128) = w; }
                }
        }
    }
};

struct Epi2 {
    static constexpr bool PERM = true;
    const bf16_t* GATE; bf16_t* MERGED;
    __device__ __forceinline__ void operator()(const f32x4 (&acc)[2][2][4][2], const pg8::Unit& u, int wr, int wc, int fr, int fq) const {
        const int row0 = u.pm * 256 + wr * 64 + fr, col = u.pn * 256 + wc * 32 + 8 * fq;
#pragma unroll
        for (int ai = 0; ai < 2; ++ai) {
            u32x4 gw[4][2], pw[4][2];
#pragma unroll
            for (int m = 0; m < 4; ++m)
#pragma unroll
                for (int bj = 0; bj < 2; ++bj) { const int row = row0 + ai * 128 + m * 16;
                    gw[m][bj] = *(const u32x4*)(GATE + (size_t)row * 4096 + u.z * 2048 + col + bj * 128);
                    pw[m][bj] = u.z ? *(const u32x4*)(MERGED + (size_t)row * 2048 + col + bj * 128) : (u32x4){0u, 0u, 0u, 0u}; }
#pragma unroll
            for (int m = 0; m < 4; ++m)
#pragma unroll
                for (int bj = 0; bj < 2; ++bj) { const int row = row0 + ai * 128 + m * 16;
                    const u32x4 g = gw[m][bj], pv = pw[m][bj]; const f32x4 v0 = acc[ai][bj][m][0], v1 = acc[ai][bj][m][1];
                    u32x4 w;
                    w.x = cvt_pk_bf16(bf_lo(g.x) * v0[0] + bf_lo(pv.x), bf_hi(g.x) * v0[1] + bf_hi(pv.x));
                    w.y = cvt_pk_bf16(bf_lo(g.y) * v0[2] + bf_lo(pv.y), bf_hi(g.y) * v0[3] + bf_hi(pv.y));
                    w.z = cvt_pk_bf16(bf_lo(g.z) * v1[0] + bf_lo(pv.z), bf_hi(g.z) * v1[1] + bf_hi(pv.z));
                    w.w = cvt_pk_bf16(bf_lo(g.w) * v1[2] + bf_lo(pv.w), bf_hi(g.w) * v1[3] + bf_hi(pv.w));
                    *(u32x4*)(MERGED + (size_t)row * 2048 + col + bj * 128) = w; }
        }
    }
};

struct Epi3 {
    static constexpr bool PERM = false;
    const float* X; float* OUT; float* SSQ;
    __device__ __forceinline__ void operator()(const f32x4 (&acc)[2][2][4][2], const pg8::Unit& u, int wr, int wc, int fr, int fq) const {
        const int row0 = u.pm * 256 + wr * 64 + fr, col0 = u.pn * 256 + wc * 32 + 4 * fq;
#pragma unroll
        for (int ai = 0; ai < 2; ++ai) {
            f32x4 xv[4][2][2];
#pragma unroll
            for (int m = 0; m < 4; ++m)
#pragma unroll
                for (int bj = 0; bj < 2; ++bj)
#pragma unroll
                    for (int n = 0; n < 2; ++n) xv[m][bj][n] = *(const f32x4*)(X + (size_t)(row0 + ai * 128 + m * 16) * 2048 + col0 + bj * 128 + n * 16);
#pragma unroll
            for (int m = 0; m < 4; ++m) {
                const int row = row0 + ai * 128 + m * 16; const size_t off = (size_t)row * 2048 + col0; float ss = 0.f;
#pragma unroll
                for (int bj = 0; bj < 2; ++bj)
#pragma unroll
                    for (int n = 0; n < 2; ++n) { const f32x4 y = xv[m][bj][n] + acc[ai][bj][m][n];
                        *(f32x4*)(OUT + off + bj * 128 + n * 16) = y; ss += (y[0] * y[0] + y[1] * y[1]) + (y[2] * y[2] + y[3] * y[3]); }
                ss += __shfl_xor(ss, 16); ss += __shfl_xor(ss, 32);
                if (fq == 0) SSQ[(size_t)row * 32 + u.pn * 4 + wc] = ss;
            }
        }
    }
};

__device__ __forceinline__ int win_src_col(int c, float& scale) {
    scale = 1.0f;
    if (c < 2048) { const int p = c & 127; if (c >= 1024) scale = 0.08838834764831845f; return (c & ~127) + (p >> 1) + 64 * (p & 1); }
    if (c < 4096 || c >= 8192) return c;
    const int l = (c - 4096) & 255, ct = (c - 4096) >> 8, bj = l >> 7, rem = l & 127, wc = rem >> 5, fq = (rem & 31) >> 3, j8 = rem & 7;
    const int ch = 64 * ct + 16 * wc + 4 * fq + (j8 & 3);
    const int qty = bj == 0 ? (j8 < 4 ? 1 : 2) : (j8 < 4 ? 0 : 3);
    return 4096 + qty * 1024 + ch;
}

__device__ void phase_prologue(const Params& p, LAS unsigned char* lds) {
    const int tid = threadIdx.x, G = gridDim.x;
    unsigned char* ws = p.ws;
    if (blockIdx.x == 0 && tid < 16) ((float*)(ws + WS_LG))[tid] = log2_sigmoid(tid < 8 ? p.lg_f[tid] : p.lg_b[tid - 8]);
    LAS float* tile = (LAS float*)lds;
    for (int tix = blockIdx.x; tix < 8192; tix += G) {
        const float* src; bf16_t* dst; int ld, Kd, n0, k0; bool isin = false;
        if (tix < 6144) { src = p.w_in; dst = (bf16_t*)(ws + WS_WIN); ld = NCOL; Kd = 2048; n0 = (tix >> 5) * 64; k0 = (tix & 31) * 64; isin = true; }
        else if (tix < 7168) { const int t = tix - 6144, z = t >> 9, tt = t & 511; src = p.w_branch + (size_t)z * 1024 * 2048; dst = (bf16_t*)(ws + WS_WB) + (size_t)z * 2048 * 1024; ld = 2048; Kd = 1024; n0 = (tt >> 4) * 64; k0 = (tt & 15) * 64; }
        else { const int t = tix - 7168; src = p.w_out; dst = (bf16_t*)(ws + WS_WO); ld = 2048; Kd = 2048; n0 = (t >> 5) * 64; k0 = (t & 31) * 64; }
        __syncthreads();
        { const int nn = tid & 63, kk0 = tid >> 6; float sc = 1.0f; const int scol = isin ? win_src_col(n0 + nn, sc) : (n0 + nn);
#pragma unroll
          for (int it = 0; it < 8; ++it) { const int kk = kk0 + 8 * it; tile[kk * 65 + nn] = src[(size_t)(k0 + kk) * ld + scol] * sc; } }
        __syncthreads();
        { const int nn = tid >> 3, kq = tid & 7; float v[8];
#pragma unroll
          for (int j = 0; j < 8; ++j) v[j] = tile[(kq * 8 + j) * 65 + nn];
          u32x4 w; w.x = cvt_pk_bf16(v[0], v[1]); w.y = cvt_pk_bf16(v[2], v[3]); w.z = cvt_pk_bf16(v[4], v[5]); w.w = cvt_pk_bf16(v[6], v[7]);
          *(u32x4*)(dst + (size_t)(n0 + nn) * Kd + k0 + kq * 8) = w; }
    }
    {
        float* COS = (float*)(ws + WS_COS); float* SIN = (float*)(ws + WS_SIN);
        for (int idx = blockIdx.x * 512 + tid; idx < SEQ * 64; idx += G * 512) {
            const int pos = idx >> 6, i = idx & 63;
            const float invf = (float)exp2(-(double)i * (13.287712379549449 / 64.0));
            const float angf = (float)pos * invf;
            const double a = (double)angf;
            const double n = rint(a * 0.15915494309189535);
            double r = fma(-n, 6.283185307179586, a); r = fma(-n, 2.4492935982947064e-16, r);
            const double qd = rint(r * 0.6366197723675814); const int q = (int)qd;
            double y = fma(-qd, 1.5707963267948966, r); y = fma(-qd, 6.123233995736766e-17, y);
            const double y2 = y * y;
            double sp = -2.5052108385441720e-08; sp = fma(sp, y2, 2.7557319223985893e-06); sp = fma(sp, y2, -1.9841269841269841e-04); sp = fma(sp, y2, 8.3333333333333332e-03); sp = fma(sp, y2, -1.6666666666666666e-01);
            const double sy = fma(y * y2, sp, y);
            double cp = 2.0876756987868099e-09; cp = fma(cp, y2, -2.7557319223985888e-07); cp = fma(cp, y2, 2.4801587301587302e-05); cp = fma(cp, y2, -1.3888888888888889e-03); cp = fma(cp, y2, 4.1666666666666664e-02); cp = fma(cp, y2, -0.5);
            const double cy = fma(y2, cp, 1.0);
            double s, c;
            switch (q & 3) { case 0: s = sy; c = cy; break; case 1: s = cy; c = -sy; break; case 2: s = -sy; c = -cy; break; default: s = -cy; c = sy; break; }
            COS[idx] = (float)c; SIN[idx] = (float)s;
        }
    }
    {
        bf16_t* H = (bf16_t*)(ws + WS_H); const int lane = tid & 63, wv = tid >> 6;
        f32x4 gn[8];
#pragma unroll
        for (int i = 0; i < 8; ++i) gn[i] = *(const f32x4*)(p.norm_gain + i * 256 + lane * 4);
        for (int row = (blockIdx.x * 8 + wv) * 2; row < T_TOK; row += G * 16) {
            f32x4 v[2][8]; float ss[2] = {0.f, 0.f};
#pragma unroll
            for (int r = 0; r < 2; ++r)
#pragma unroll
                for (int i = 0; i < 8; ++i) v[r][i] = *(const f32x4*)(p.x + (size_t)(row + r) * DM + i * 256 + lane * 4);
#pragma unroll
            for (int r = 0; r < 2; ++r) {
#pragma unroll
                for (int i = 0; i < 8; ++i) ss[r] += (v[r][i][0] * v[r][i][0] + v[r][i][1] * v[r][i][1]) + (v[r][i][2] * v[r][i][2] + v[r][i][3] * v[r][i][3]);
#pragma unroll
                for (int o = 32; o >= 1; o >>= 1) ss[r] += __shfl_xor(ss[r], o);
                const float rstd = rsqrtf(ss[r] * (1.0f / 2048.0f) + 1e-6f);
#pragma unroll
                for (int i = 0; i < 8; ++i) {
                    u32x2 w; w.x = cvt_pk_bf16(v[r][i][0] * rstd * gn[i][0], v[r][i][1] * rstd * gn[i][1]); w.y = cvt_pk_bf16(v[r][i][2] * rstd * gn[i][2], v[r][i][3] * rstd * gn[i][3]);
                    *(u32x2*)(H + (size_t)(row + r) * DM + i * 256 + lane * 4) = w; }
            }
        }
    }
}

__device__ __forceinline__ void mm128(f32x4 (&acc)[4][2], const LAS bf16_t* At, const LAS bf16_t* Bt, int wr, int wc, int fr, int fq) {
    __builtin_amdgcn_sched_barrier(0);
#pragma unroll 1
    for (int kb = 0; kb < 4; ++kb) {
        bf16x8 a[4], b[2];
#pragma unroll
        for (int m = 0; m < 4; ++m) a[m] = *(const LAS bf16x8*)(At + (64 * wr + 16 * m + fr) * TS + kb * 32 + fq * 8);
#pragma unroll
        for (int n = 0; n < 2; ++n) b[n] = *(const LAS bf16x8*)(Bt + (32 * wc + 16 * n + fr) * TS + kb * 32 + fq * 8);
#pragma unroll
        for (int m = 0; m < 4; ++m)
#pragma unroll
            for (int n = 0; n < 2; ++n) acc[m][n] = __builtin_amdgcn_mfma_f32_16x16x32_bf16(b[n], a[m], acc[m][n], 0, 0, 0);
    }
}
__device__ __forceinline__ void zero_acc(f32x4 (&acc)[4][2]) {
#pragma unroll
    for (int m = 0; m < 4; ++m)
#pragma unroll
        for (int n = 0; n < 2; ++n) acc[m][n] = (f32x4){0.f, 0.f, 0.f, 0.f};
}
__device__ __forceinline__ void stage_nat(LAS bf16_t* dst, const bf16_t* src, size_t ld, int tid) {
#pragma unroll
    for (int it = 0; it < 4; ++it) { const int idx = tid + 512 * it, row = idx >> 4, cg8 = idx & 15;
        const u32x4 v = *(const u32x4*)(src + (size_t)row * ld + cg8 * 8); *(LAS u32x4*)(dst + row * TS + cg8 * 8) = v; }
}

__device__ void phase_r1(const Params& p, LAS unsigned char* lds) {
    const int tid = threadIdx.x, wid = __builtin_amdgcn_readfirstlane(tid >> 6), lane = tid & 63, wr = wid >> 2, wc = wid & 3, fr = lane & 15, fq = lane >> 4;
    LAS bf16_t* VT = (LAS bf16_t*)lds; LAS bf16_t* KfT = VT + 128 * TS; LAS bf16_t* KbT = KfT + 128 * TS;
    const bf16_t* Kg = (const bf16_t*)(p.ws + WS_K); const bf16_t* Vg = (const bf16_t*)(p.ws + WS_V); bf16_t* KV = (bf16_t*)(p.ws + WS_KV);
    for (int unit = blockIdx.x; unit < 2048; unit += gridDim.x) {
        const int bh = unit >> 7, n = unit & 127, b = bh >> 3, h = bh & 7;
        const float lgf = ((const float*)(p.ws + WS_LG))[h], lgb = ((const float*)(p.ws + WS_LG))[8 + h];
        const size_t rowbase = (size_t)b * SEQ + (size_t)n * 128;
        __syncthreads();
        { const int s = tid & 127, eg0 = tid >> 7;
          const float wf = exp2f((float)(128 - s) * lgf), wb = exp2f((float)(s + 1) * lgb);
#pragma unroll
          for (int it = 0; it < 4; ++it) { const int eg = eg0 + 4 * it;
              const u32x4 kw = *(const u32x4*)(Kg + (rowbase + s) * 1024 + h * 128 + eg * 8);
              const u32x4 vw = *(const u32x4*)(Vg + (rowbase + s) * 1024 + h * 128 + eg * 8);
              const unsigned kk[4] = {kw.x, kw.y, kw.z, kw.w}, vv[4] = {vw.x, vw.y, vw.z, vw.w};
#pragma unroll
              for (int j = 0; j < 4; ++j) { const float k0 = bf_lo(kk[j]), k1 = bf_hi(kk[j]); const int r0 = (eg * 8 + 2 * j) * TS + s, r1 = r0 + TS;
                  KfT[r0] = f2bf(k0 * wf); KfT[r1] = f2bf(k1 * wf); KbT[r0] = f2bf(k0 * wb); KbT[r1] = f2bf(k1 * wb);
                  VT[r0] = (bf16_t)(vv[j] & 0xffffu); VT[r1] = (bf16_t)(vv[j] >> 16); } } }
        __syncthreads();
#pragma unroll
        for (int dir = 0; dir < 2; ++dir) {
            f32x4 acc[4][2]; zero_acc(acc);
            mm128(acc, VT, dir ? KbT : KfT, wr, wc, fr, fq);
            bf16_t* dst = KV + ((size_t)((dir * 16 + bh) * 128 + n)) * 16384;
#pragma unroll
            for (int m = 0; m < 4; ++m)
#pragma unroll
                for (int nn = 0; nn < 2; ++nn) { const int e = 64 * wr + 16 * m + fr, d = 32 * wc + 16 * nn + 4 * fq;
                    u32x2 w; w.x = cvt_pk_bf16(acc[m][nn][0], acc[m][nn][1]); w.y = cvt_pk_bf16(acc[m][nn][2], acc[m][nn][3]);
                    *(u32x2*)(dst + e * 128 + d) = w; }
        }
    }
}

__device__ void phase_conv(const Params& p) {
    const int tid = threadIdx.x; const int cg4 = tid & 255, half = tid >> 8;
    const unsigned* UW = (const unsigned*)(p.ws + WS_UW); bf16_t* BR1 = (bf16_t*)(p.ws + WS_BR) + (size_t)T_TOK * 1024;
    const f32x4 k0 = *(const f32x4*)(p.conv_w + cg4 * 4), k1 = *(const f32x4*)(p.conv_w + 1024 + cg4 * 4), k2 = *(const f32x4*)(p.conv_w + 2048 + cg4 * 4);
    for (int unit = blockIdx.x; unit < 512; unit += gridDim.x) {
        const int tb = unit * 64 + half * 32;
        for (int bt = 0; bt < 4; ++bt) {
            const int t0 = tb + bt * 8;
            u32x4 r[10];
#pragma unroll
            for (int j = 0; j < 10; ++j) {
                const bool valid = !((j == 0 && (t0 & (SEQ - 1)) == 0) || (j == 9 && ((t0 + 8) & (SEQ - 1)) == 0));
                r[j] = valid ? *(const u32x4*)(UW + (size_t)(t0 - 1 + j) * 1024 + cg4 * 4) : (u32x4){0u, 0u, 0u, 0u}; }
#pragma unroll
            for (int i = 0; i < 8; ++i) {
                const u32x4 prev = r[i], cur = r[i + 1], nxt = r[i + 2];
                const float c0 = k0[0] * bf_lo(prev.x) + k1[0] * bf_lo(cur.x) + k2[0] * bf_lo(nxt.x);
                const float c1 = k0[1] * bf_lo(prev.y) + k1[1] * bf_lo(cur.y) + k2[1] * bf_lo(nxt.y);
                const float c2 = k0[2] * bf_lo(prev.z) + k1[2] * bf_lo(cur.z) + k2[2] * bf_lo(nxt.z);
                const float c3 = k0[3] * bf_lo(prev.w) + k1[3] * bf_lo(cur.w) + k2[3] * bf_lo(nxt.w);
                u32x2 w; w.x = cvt_pk_bf16(c0 * bf_hi(cur.x), c1 * bf_hi(cur.y)); w.y = cvt_pk_bf16(c2 * bf_hi(cur.z), c3 * bf_hi(cur.w));
                *(u32x2*)(BR1 + (size_t)(t0 + i) * 1024 + cg4 * 4) = w;
            }
        }
    }
}

__device__ void phase_scan(const Params& p) {
    const int tid = threadIdx.x;
    const bf16_t* KV = (const bf16_t*)(p.ws + WS_KV); bf16_t* ST = (bf16_t*)(p.ws + WS_ST);
    for (int item = blockIdx.x * 512 + tid; item < 131072; item += gridDim.x * 512) {
        const int q = item & 4095, bh = (item >> 12) & 15, dir = item >> 16, h = bh & 7;
        const float lg = ((const float*)(p.ws + WS_LG))[dir * 8 + h];
        const float a = exp2f(128.0f * lg);
        const size_t base = (size_t)((dir * 16 + bh) * 128) * 16384 + (size_t)q * 4;
        float s0 = 0.f, s1 = 0.f, s2 = 0.f, s3 = 0.f;
        for (int step = 0; step < 128; step += 8) {
            u32x2 kv[8];
#pragma unroll
            for (int j = 0; j < 8; ++j) { const int n = dir ? 127 - (step + j) : (step + j); kv[j] = *(const u32x2*)(KV + base + (size_t)n * 16384); }
#pragma unroll
            for (int j = 0; j < 8; ++j) { const int n = dir ? 127 - (step + j) : (step + j);
                u32x2 w; w.x = cvt_pk_bf16(s0, s1); w.y = cvt_pk_bf16(s2, s3); *(u32x2*)(ST + base + (size_t)n * 16384) = w;
                s0 = a * s0 + bf_lo(kv[j].x); s1 = a * s1 + bf_hi(kv[j].x); s2 = a * s2 + bf_lo(kv[j].y); s3 = a * s3 + bf_hi(kv[j].y); }
        }
    }
}

__device__ __forceinline__ void ld_nat(u32x4 (&r)[4], const bf16_t* src, size_t ld, int tid) {
#pragma unroll
    for (int it = 0; it < 4; ++it) { const int idx = tid + 512 * it, row = idx >> 4, cg8 = idx & 15; r[it] = *(const u32x4*)(src + (size_t)row * ld + cg8 * 8); }
}
__device__ __forceinline__ void st_nat(LAS bf16_t* dst, const u32x4 (&r)[4], int tid) {
#pragma unroll
    for (int it = 0; it < 4; ++it) { const int idx = tid + 512 * it, row = idx >> 4, cg8 = idx & 15; *(LAS u32x4*)(dst + row * TS + cg8 * 8) = r[it]; }
}
__device__ __forceinline__ void ld_tr(u32x4 (&r)[4], const bf16_t* src, int tid) {
    const int s = tid & 127, eg0 = tid >> 7;
#pragma unroll
    for (int it = 0; it < 4; ++it) r[it] = *(const u32x4*)(src + (size_t)s * 1024 + (eg0 + 4 * it) * 8);
}
__device__ __forceinline__ void st_tr(LAS bf16_t* dst, const u32x4 (&r)[4], int tid) {
    const int s = tid & 127, eg0 = tid >> 7;
#pragma unroll
    for (int it = 0; it < 4; ++it) { const int eg = eg0 + 4 * it; const unsigned vv[4] = {r[it].x, r[it].y, r[it].z, r[it].w};
#pragma unroll
        for (int j = 0; j < 4; ++j) { const int r0 = (eg * 8 + 2 * j) * TS + s; dst[r0] = (bf16_t)(vv[j] & 0xffffu); dst[r0 + TS] = (bf16_t)(vv[j] >> 16); } }
}

__device__ void phase_r3(const Params& p, LAS unsigned char* lds) {
    const int tid = threadIdx.x, wid = __builtin_amdgcn_readfirstlane(tid >> 6), lane = tid & 63, wr = wid >> 2, wc = wid & 3, fr = lane & 15, fq = lane >> 4;
    LAS bf16_t* Qs = (LAS bf16_t*)lds; LAS bf16_t* Ks = Qs + 128 * TS; LAS bf16_t* VT = Ks + 128 * TS; LAS bf16_t* Ss = VT + 128 * TS; LAS float* red = (LAS float*)(Ss + 128 * TS);
    const bf16_t* Qg = (const bf16_t*)(p.ws + WS_Q); const bf16_t* Kg = (const bf16_t*)(p.ws + WS_K); const bf16_t* Vg = (const bf16_t*)(p.ws + WS_V);
    const bf16_t* SG = (const bf16_t*)(p.ws + WS_SG); const bf16_t* ST = (const bf16_t*)(p.ws + WS_ST); bf16_t* BR0 = (bf16_t*)(p.ws + WS_BR);
    const int G = gridDim.x;
    u32x4 rq[4], rk[4];
    { const int unit = blockIdx.x;
      if (unit < 2048) { const int bh = unit >> 7, n = unit & 127, b = bh >> 3, h = bh & 7; const size_t rowbase = (size_t)b * SEQ + (size_t)n * 128;
        ld_nat(rq, Qg + rowbase * 1024 + h * 128, 1024, tid); ld_nat(rk, Kg + rowbase * 1024 + h * 128, 1024, tid); } }
    for (int unit = blockIdx.x; unit < 2048; unit += G) {
        const int bh = unit >> 7, n = unit & 127, b = bh >> 3, h = bh & 7;
        const float lgf = ((const float*)(p.ws + WS_LG))[h], lgb = ((const float*)(p.ws + WS_LG))[8 + h];
        const size_t rowbase = (size_t)b * SEQ + (size_t)n * 128;
        u32x4 rv[4], rs[4], rb[4];
        ld_tr(rv, Vg + rowbase * 1024 + h * 128, tid); ld_nat(rs, ST + ((size_t)((0 * 16 + bh) * 128 + n)) * 16384, 128, tid);
        ld_nat(rb, ST + ((size_t)((1 * 16 + bh) * 128 + n)) * 16384, 128, tid);
        u32x2 sg[4][2];
#pragma unroll
        for (int nn = 0; nn < 2; ++nn) { const int e0 = 32 * wc + 16 * nn + 4 * fq;
#pragma unroll
            for (int m = 0; m < 4; ++m) sg[m][nn] = *(const u32x2*)(SG + (rowbase + 64 * wr + 16 * m + fr) * 1024 + h * 128 + e0); }
        __builtin_amdgcn_sched_barrier(0);
        __syncthreads();
        st_nat(Qs, rq, tid); st_nat(Ks, rk, tid); st_nat(Ss, rs, tid); st_tr(VT, rv, tid);
        __builtin_amdgcn_sched_barrier(0);
        __syncthreads();
        f32x4 accP[4][2], acc1[4][2], acc2[4][2];
        zero_acc(accP); mm128(accP, Qs, Ks, wr, wc, fr, fq);
        float rowf[4], rowb[4], colf[2][4], colb[2][4];
#pragma unroll
        for (int m = 0; m < 4; ++m) { const float tf = (float)(64 * wr + 16 * m + fr); rowf[m] = __builtin_amdgcn_exp2f(tf * lgf); rowb[m] = __builtin_amdgcn_exp2f(-tf * lgb); }
#pragma unroll
        for (int nn = 0; nn < 2; ++nn)
#pragma unroll
            for (int j = 0; j < 4; ++j) { const float sf = (float)(32 * wc + 16 * nn + 4 * fq + j); colf[nn][j] = __builtin_amdgcn_exp2f(-sf * lgf); colb[nn][j] = __builtin_amdgcn_exp2f(sf * lgb); }
#pragma unroll
        for (int m = 0; m < 4; ++m)
#pragma unroll
            for (int nn = 0; nn < 2; ++nn)
#pragma unroll
                for (int j = 0; j < 4; ++j) { const int t = 64 * wr + 16 * m + fr, s = 32 * wc + 16 * nn + 4 * fq + j;
                    accP[m][nn][j] *= (s <= t) ? rowf[m] * colf[nn][j] : rowb[m] * colb[nn][j]; }
        zero_acc(acc1); mm128(acc1, Qs, Ss, wr, wc, fr, fq);
#pragma unroll
        for (int m = 0; m < 4; ++m)
#pragma unroll
            for (int nn = 0; nn < 2; ++nn) acc1[m][nn] *= rowf[m];
        __syncthreads();
#pragma unroll
        for (int m = 0; m < 4; ++m)
#pragma unroll
            for (int nn = 0; nn < 2; ++nn) { const int t = 64 * wr + 16 * m + fr, s = 32 * wc + 16 * nn + 4 * fq;
                u32x2 w; w.x = cvt_pk_bf16(accP[m][nn][0], accP[m][nn][1]); w.y = cvt_pk_bf16(accP[m][nn][2], accP[m][nn][3]);
                *(LAS u32x2*)(Ks + t * TS + s) = w; }
        st_nat(Ss, rb, tid);
        __builtin_amdgcn_sched_barrier(0);
        { const int nu = unit + G;
          if (nu < 2048) { const int bh2 = nu >> 7, n2 = nu & 127, b2 = bh2 >> 3, h2 = bh2 & 7; const size_t rowbase2 = (size_t)b2 * SEQ + (size_t)n2 * 128;
            ld_nat(rq, Qg + rowbase2 * 1024 + h2 * 128, 1024, tid); ld_nat(rk, Kg + rowbase2 * 1024 + h2 * 128, 1024, tid); } }
        __builtin_amdgcn_sched_barrier(0);
        __syncthreads();
        zero_acc(acc2); mm128(acc2, Qs, Ss, wr, wc, fr, fq);
        { const float g127 = __builtin_amdgcn_exp2f(127.0f * lgb);
#pragma unroll
          for (int m = 0; m < 4; ++m) { const float sc = g127 * rowb[m];
#pragma unroll
            for (int nn = 0; nn < 2; ++nn) acc1[m][nn] += acc2[m][nn] * sc; } }
        mm128(acc1, Ks, VT, wr, wc, fr, fq);
#pragma unroll
        for (int m = 0; m < 4; ++m) { float ss = 0.f;
#pragma unroll
            for (int nn = 0; nn < 2; ++nn) ss += (acc1[m][nn][0] * acc1[m][nn][0] + acc1[m][nn][1] * acc1[m][nn][1]) + (acc1[m][nn][2] * acc1[m][nn][2] + acc1[m][nn][3] * acc1[m][nn][3]);
            ss += __shfl_xor(ss, 16); ss += __shfl_xor(ss, 32);
            if (fq == 0) red[(64 * wr + 16 * m + fr) * 4 + wc] = ss; }
        __syncthreads();
#pragma unroll
        for (int m = 0; m < 4; ++m) { const int t = 64 * wr + 16 * m + fr; const f32x4 r4 = *(const LAS f32x4*)(red + t * 4);
            const float rstd = __builtin_amdgcn_rsqf(((r4[0] + r4[1]) + (r4[2] + r4[3])) * (1.0f / 128.0f) + 1e-6f);
#pragma unroll
            for (int nn = 0; nn < 2; ++nn) { const int e0 = 32 * wc + 16 * nn + 4 * fq; const f32x4 gg = *(const f32x4*)(p.gn_gain + h * 128 + e0);
                u32x2 w; w.x = cvt_pk_bf16(acc1[m][nn][0] * rstd * gg[0] * bf_lo(sg[m][nn].x), acc1[m][nn][1] * rstd * gg[1] * bf_hi(sg[m][nn].x));
                w.y = cvt_pk_bf16(acc1[m][nn][2] * rstd * gg[2] * bf_lo(sg[m][nn].y), acc1[m][nn][3] * rstd * gg[3] * bf_hi(sg[m][nn].y));
                *(u32x2*)(BR0 + (rowbase + t) * 1024 + h * 128 + e0) = w; } }
    }
}

__device__ void phase_final(const Params& p) {
    const int tid = threadIdx.x, lane = tid & 63, wv = tid >> 6; const float* SSQ = (const float*)(p.ws + WS_SSQ);
    f32x4 g[8];
#pragma unroll
    for (int i = 0; i < 8; ++i) g[i] = *(const f32x4*)(p.final_gain + i * 256 + lane * 4);
    for (int row = (blockIdx.x * 8 + wv) * 2; row < T_TOK; row += gridDim.x * 16) {
        float ss[2]; f32x4 y[2][8];
#pragma unroll
        for (int r = 0; r < 2; ++r) { ss[r] = lane < 32 ? SSQ[(size_t)(row + r) * 32 + lane] : 0.f;
#pragma unroll
            for (int i = 0; i < 8; ++i) y[r][i] = *(const f32x4*)(p.out + (size_t)(row + r) * DM + i * 256 + lane * 4); }
#pragma unroll
        for (int r = 0; r < 2; ++r) {
#pragma unroll
            for (int o = 32; o >= 1; o >>= 1) ss[r] += __shfl_xor(ss[r], o);
            const float rstd = rsqrtf(ss[r] * (1.0f / 2048.0f) + 1e-6f);
#pragma unroll
            for (int i = 0; i < 8; ++i) *(f32x4*)(p.out + (size_t)(row + r) * DM + i * 256 + lane * 4) = y[r][i] * rstd * g[i]; }
    }
}


#define XB_TMO      128
#define XB_XCNT(j)  (256  + 64 * (j))
#define XB_XSUB(j)  (1280 + 64 * (j))
#define XB_XGEN(j)  (2304 + 64 * (j))
#define XB_TOP      3328
#define XB_TOPGEN   3392
#define XCD_BAR_WORDS 3456
#define XB_SPIN_CAP (1u << 18)
__device__ __forceinline__ unsigned xb_ld(unsigned* p)              { return __hip_atomic_load(p, __ATOMIC_RELAXED, __HIP_MEMORY_SCOPE_AGENT); }
__device__ __forceinline__ unsigned xb_add(unsigned* p, unsigned v) { return __hip_atomic_fetch_add(p, v, __ATOMIC_RELAXED, __HIP_MEMORY_SCOPE_AGENT); }
__device__ __forceinline__ unsigned xb_xcc_id() { return (unsigned)__builtin_amdgcn_s_getreg((3 << 11) | 20) & 0xFu; }
#define XB_SPIN(cond, bar) do { unsigned _sp = 0; while (cond) { __builtin_amdgcn_s_sleep(1); \
    if ((++_sp & 255u) == 0u) { if (xb_ld(&(bar)[XB_TMO])) break; if (_sp > XB_SPIN_CAP) { atomicAdd(&(bar)[XB_TMO], 1u); break; } } } } while (0)
struct XcdBarrier { unsigned* bar; unsigned x; volatile LAS unsigned* st; };
__device__ __forceinline__ XcdBarrier xcd_barrier_post(unsigned* bar, volatile LAS unsigned* st) {
    XcdBarrier b; b.bar = bar; b.x = xb_xcc_id(); b.st = st;
    if (threadIdx.x == 0) (void)xb_add(&bar[XB_XCNT(b.x)], 1u);
    return b;
}
__device__ __forceinline__ void xcd_barrier_complete(unsigned* bar, unsigned x, unsigned& nloc, unsigned& nx) {
    const unsigned G = gridDim.x * gridDim.y * gridDim.z;
    unsigned sum, cnt, mine, sp = 0u;
    for (;;) {
        sum = 0u; cnt = 0u; mine = 0u;
#pragma unroll
        for (unsigned j = 0; j < 16; ++j) { const unsigned c = xb_ld(&bar[XB_XCNT(j)]); sum += c; cnt += (c > 0u) ? 1u : 0u; mine = (j == x) ? c : mine; }
        if (sum == G) break;
        __builtin_amdgcn_s_sleep(1);
        if ((++sp & 255u) == 0u) { if (xb_ld(&bar[XB_TMO])) break; if (sp > XB_SPIN_CAP) { atomicAdd(&bar[XB_TMO], 1u); break; } }
    }
    nloc = mine > 0u ? mine : 1u; nx = cnt > 0u ? cnt : 1u;
}
__device__ __forceinline__ void xcd_barrier(const XcdBarrier& b) {
    asm volatile("s_waitcnt vmcnt(0)" ::: "memory");
    __syncthreads();
    if (threadIdx.x == 0) {
        unsigned* bar = b.bar;
        __builtin_amdgcn_s_waitcnt(0);
        unsigned nloc = b.st[0], nx = b.st[1];
        if (nloc == 0u) { xcd_barrier_complete(bar, b.x, nloc, nx); b.st[0] = nloc; b.st[1] = nx; }
        const unsigned old = xb_add(&bar[XB_XSUB(b.x)], 1u);
        const unsigned gen = old / nloc;
        if (old + 1u == (gen + 1u) * nloc) {
            __builtin_amdgcn_fence(__ATOMIC_RELEASE, "agent");
            asm volatile("s_waitcnt vmcnt(0)" ::: "memory");
            const unsigned og = xb_add(&bar[XB_TOP], 1u);
            const unsigned tg = og / nx;
            if (og + 1u == (tg + 1u) * nx) xb_add(&bar[XB_TOPGEN], 1u);
            else XB_SPIN(xb_ld(&bar[XB_TOPGEN]) == tg, bar);
            __builtin_amdgcn_fence(__ATOMIC_ACQUIRE, "agent");
            xb_add(&bar[XB_XGEN(b.x)], 1u);
            asm volatile("s_waitcnt vmcnt(0)" ::: "memory");
        } else {
            XB_SPIN(xb_ld(&bar[XB_XGEN(b.x)]) == gen, bar);
            __builtin_amdgcn_fence(__ATOMIC_ACQUIRE, "agent");
            asm volatile("s_waitcnt vmcnt(0)" ::: "memory");
        }
    }
    __syncthreads();
}

__device__ __forceinline__ void grid_barrier(cg::grid_group& grid) {
    asm volatile("s_waitcnt vmcnt(0) lgkmcnt(0)" ::: "memory");
    grid.sync();
    __builtin_amdgcn_fence(__ATOMIC_ACQUIRE, "agent");
    asm volatile("s_waitcnt vmcnt(0)" ::: "memory");
}

__global__ void __launch_bounds__(512, 2) fwd_megakernel(Params p) {
    extern __shared__ __attribute__((aligned(16))) unsigned char lds_raw[];
    LAS unsigned char* lds = (LAS unsigned char*)lds_raw;
    cg::grid_group grid = cg::this_grid();
    unsigned char* ws = p.ws;
    const int G = gridDim.x, c = blockIdx.x;
    volatile LAS unsigned* xst = (volatile LAS unsigned*)(lds + LDS_BYTES - 16);
    if (threadIdx.x < 2) xst[threadIdx.x] = 0u;
    __syncthreads();
    const XcdBarrier xbar = xcd_barrier_post((unsigned*)(ws + WS_BAR), xst);

#ifndef PHM
#define PHM 255
#endif
    if (PHM & 1) phase_prologue(p, lds);
    if (p.out == nullptr) grid_barrier(grid);
    xcd_barrier(xbar);
    if (PHM & 2) {
        pg8::Gemm g{(const bf16_t*)(ws + WS_H), (const bf16_t*)(ws + WS_WIN), T_TOK, NCOL, 2048, 0, 0};
        pg8::Order S; S.init(T_TOK, NCOL, G, c, 0);
        Epi1 E{(bf16_t*)(ws + WS_Q), (bf16_t*)(ws + WS_K), (bf16_t*)(ws + WS_V), (bf16_t*)(ws + WS_SG), (bf16_t*)(ws + WS_UW), (bf16_t*)(ws + WS_GATE), (const float*)(ws + WS_COS), (const float*)(ws + WS_SIN)};
        pg8::gemm_phase<Epi1>(lds, g, S, E);
    }
    xcd_barrier(xbar);
    if (PHM & 4) phase_r1(p, lds);
    if (PHM & 4) phase_conv(p);
    xcd_barrier(xbar);
    if (PHM & 8) phase_scan(p);
    xcd_barrier(xbar);
    if (PHM & 16) phase_r3(p, lds);
    xcd_barrier(xbar);
    if (PHM & 32) {
        pg8::Gemm g{(const bf16_t*)(ws + WS_BR), (const bf16_t*)(ws + WS_WB), T_TOK, 2048, 1024, (size_t)T_TOK * 1024 * 2, (size_t)2048 * 1024 * 2};
        pg8::Order S; S.init(T_TOK, 2048, G, c, 1);
        Epi2 E{(const bf16_t*)(ws + WS_GATE), (bf16_t*)(ws + WS_MERGED)};
        pg8::gemm_phase<Epi2>(lds, g, S, E);
    }
    xcd_barrier(xbar);
    if (PHM & 64) {
        pg8::Gemm g{(const bf16_t*)(ws + WS_MERGED), (const bf16_t*)(ws + WS_WO), T_TOK, 2048, 2048, 0, 0};
        pg8::Order S; S.init(T_TOK, 2048, G, c, 0);
        Epi3 E{p.x, p.out, (float*)(ws + WS_SSQ)};
        pg8::gemm_phase<Epi3>(lds, g, S, E);
    }
    xcd_barrier(xbar);
    if (PHM & 128) phase_final(p);
}

extern "C" void kernel_launch(void* const* d_in, const int* in_sizes, int n_in, void* d_out, int out_size, void* d_ws, size_t ws_size, hipStream_t stream) {
    static int grid_blocks = 0;
    if (!grid_blocks) {
        if (n_in != 10 || out_size != T_TOK * DM || ws_size < WS_END) { fprintf(stderr, "kernel_launch: unexpected shapes (n_in %d out %d ws %zu)\n", n_in, out_size, ws_size); grid_blocks = -1; return; }
        int dev = 0, cus = 0, per_cu = 0;
        hipGetDevice(&dev);
        hipDeviceGetAttribute(&cus, hipDeviceAttributeMultiprocessorCount, dev);
        if (hipFuncSetAttribute((const void*)fwd_megakernel, hipFuncAttributeMaxDynamicSharedMemorySize, LDS_BYTES) != hipSuccess) { fprintf(stderr, "kernel_launch: hipFuncSetAttribute failed\n"); grid_blocks = -1; return; }
        hipOccupancyMaxActiveBlocksPerMultiprocessor(&per_cu, (const void*)fwd_megakernel, 512, LDS_BYTES);
        if (per_cu < 1) { fprintf(stderr, "kernel_launch: occupancy query says %d blocks per CU\n", per_cu); per_cu = 1; }
        grid_blocks = cus * per_cu;
    }
    if (grid_blocks < 0) return;
    Params p{};
    p.x = (const float*)d_in[0]; p.norm_gain = (const float*)d_in[1]; p.w_in = (const float*)d_in[2]; p.lg_f = (const float*)d_in[3]; p.lg_b = (const float*)d_in[4];
    p.gn_gain = (const float*)d_in[5]; p.conv_w = (const float*)d_in[6]; p.w_branch = (const float*)d_in[7]; p.w_out = (const float*)d_in[8]; p.final_gain = (const float*)d_in[9];
    p.out = (float*)d_out; p.ws = (unsigned char*)d_ws;
    if (hipMemsetAsync((char*)d_ws + WS_BAR, 0, XCD_BAR_WORDS * 4, stream) != hipSuccess) { fprintf(stderr, "kernel_launch: memset of barrier words failed\n"); return; }
    void* args[] = {&p};
    hipError_t e = hipLaunchCooperativeKernel((const void*)fwd_megakernel, dim3(grid_blocks), dim3(512), args, LDS_BYTES, stream);
    if (e != hipSuccess) fprintf(stderr, "cooperative launch failed: %s (grid %d)\n", hipGetErrorString(e), grid_blocks);
}
```
